# Optimizing an MI355X kernel written in HIP

```python
import math
import jax, jax.numpy as jnp
from jax import lax
import numpy as np

D_MODEL = 2048
BATCH = 4
SEQ = 2048
DEPTH = 1
DEC_BATCH = 8
DEC_SEQ = 8
PAST_LEN = 16384
PAGE_SIZE = 128

N_HEADS_ATTN = 8
HEAD_DIM_QK = 64
HEAD_DIM_V = 2 * HEAD_DIM_QK
ATTN_WIDTH = N_HEADS_ATTN * HEAD_DIM_V
CONV_WIDTH = D_MODEL - ATTN_WIDTH
CONV_GROUPS = 8
CONV_KERNEL = 31
D_FF = 5632
D_PLE = 256
Q_BLOCK = 128
RMS_EPS = 1e-6
LN_EPS = 1e-5
NEG_INF = -1e30
QK_COLS = N_HEADS_ATTN * 2 * HEAD_DIM_QK
IN_COLS = 2 * QK_COLS + ATTN_WIDTH + 2 * CONV_WIDTH
POOL_NUM, POOL_DEN = 5, 4

kernel_name = "hymba_diffattn_conformer_step"


def rms_norm(x, g):
    xf = x.astype(jnp.float32)
    y = xf * lax.rsqrt(jnp.mean(xf * xf, axis=-1, keepdims=True) + RMS_EPS)
    return (y * g).astype(x.dtype)


def group_layer_norm(x, g, b):
    xf = x.astype(jnp.float32).reshape(*x.shape[:-1], CONV_GROUPS, -1)
    mu = jnp.mean(xf, axis=-1, keepdims=True)
    var = jnp.mean(jnp.square(xf - mu), axis=-1, keepdims=True)
    y = ((xf - mu) * lax.rsqrt(var + LN_EPS)).reshape(x.shape)
    return (y * g + b).astype(x.dtype)


def swiglu(x, w_gate, w_up, w_down):
    return (jax.nn.silu(x @ w_gate) * (x @ w_up)) @ w_down


def alibi_slopes():
    return jnp.asarray(np.array([2.0 ** (-8.0 * (h + 1) / N_HEADS_ATTN) for h in range(N_HEADS_ATTN)], dtype=np.float32))


def alibi_bias(qpos, kpos):
    dist = (qpos[:, None] - kpos[None, :]).astype(jnp.float32)
    return jnp.where(dist[None] >= 0, -alibi_slopes()[:, None, None] * dist[None], NEG_INF)


def lambda_init(layer_idx):
    return 0.8 - 0.6 * math.exp(-0.3 * layer_idx)


def diff_weights(s, lam):
    p = jax.nn.softmax(s, axis=-1)
    return p[:, :, 0] - lam * p[:, :, 1]


def diff_attn_prompt(q, k, v, lam):
    b, s = q.shape[:2]
    nblk = s // Q_BLOCK
    scale = HEAD_DIM_QK ** -0.5
    kpos = jnp.arange(s)
    qb = q.reshape(b, nblk, Q_BLOCK, *q.shape[2:]).swapaxes(0, 1)

    def one_block(args):
        q_blk, i = args
        qpos = i * Q_BLOCK + jnp.arange(Q_BLOCK)
        sc = jnp.einsum('bqhmd,bkhmd->bhmqk', q_blk, k, preferred_element_type=jnp.float32) * scale
        w = diff_weights(sc + alibi_bias(qpos, kpos)[None, :, None], lam)
        return jnp.einsum('bhqk,bkhd->bqhd', w.astype(v.dtype), v, preferred_element_type=jnp.float32).astype(v.dtype)

    out = lax.map(one_block, (qb, jnp.arange(nblk)))
    return out.swapaxes(0, 1).reshape(b, s, N_HEADS_ATTN, HEAD_DIM_V)


def diff_attn_sample(q, k_new, v_new, k_past, v_past, lam):
    t = q.shape[1]
    p = k_past.shape[1]
    scale = HEAD_DIM_QK ** -0.5
    s_past = jnp.einsum('bqhmd,bkhmd->bhmqk', q, k_past, preferred_element_type=jnp.float32)
    s_new = jnp.einsum('bqhmd,bkhmd->bhmqk', q, k_new, preferred_element_type=jnp.float32)
    sc = jnp.concatenate([s_past, s_new], axis=-1) * scale
    qpos = p + jnp.arange(t)
    kpos = jnp.arange(p + t)
    w = diff_weights(sc + alibi_bias(qpos, kpos)[None, :, None], lam).astype(v_new.dtype)
    out = (jnp.einsum('bhqk,bkhd->bqhd', w[..., :p], v_past, preferred_element_type=jnp.float32)
           + jnp.einsum('bhqk,bkhd->bqhd', w[..., p:], v_new, preferred_element_type=jnp.float32))
    return out.astype(v_new.dtype)


def conformer_conv(c_in, conv_prev, w_dw, b_dw, g_cn, b_cn):
    a, g = jnp.split(c_in, 2, axis=-1)
    u = a * jax.nn.sigmoid(g)
    u_ext = jnp.concatenate([conv_prev.astype(u.dtype), u], axis=1)
    y = lax.conv_general_dilated(u_ext, w_dw[:, None, :].astype(u.dtype), window_strides=(1,), padding='VALID',
                                 dimension_numbers=('NWC', 'WIO', 'NWC'), feature_group_count=CONV_WIDTH) + b_dw
    y = jax.nn.silu(group_layer_norm(y, g_cn, b_cn))
    return y, u_ext[:, -(CONV_KERNEL - 1):]


def layer_forward(h, p_l, conv_prev, attend, layer_idx, W):
    b, s, _ = h.shape
    h = h + 0.5 * swiglu(rms_norm(h, W['g_ffn1']), W['w_ffn1_gate'], W['w_ffn1_up'], W['w_ffn1_down'])
    u = rms_norm(h, W['g_mix']) @ W['w_in']
    q = u[..., :QK_COLS].reshape(b, s, N_HEADS_ATTN, 2, HEAD_DIM_QK)
    k = u[..., QK_COLS:2 * QK_COLS].reshape(b, s, N_HEADS_ATTN, 2, HEAD_DIM_QK)
    v = u[..., 2 * QK_COLS:2 * QK_COLS + ATTN_WIDTH].reshape(b, s, N_HEADS_ATTN, HEAD_DIM_V)
    c_in = u[..., 2 * QK_COLS + ATTN_WIDTH:]
    lam_init = lambda_init(layer_idx)
    lam = (jnp.exp(jnp.sum(W['lambda_q1'].astype(jnp.float32) * W['lambda_k1'].astype(jnp.float32)))
           - jnp.exp(jnp.sum(W['lambda_q2'].astype(jnp.float32) * W['lambda_k2'].astype(jnp.float32))) + lam_init)
    o_attn = attend(q, k, v, lam)
    o_attn = (rms_norm(o_attn, W['g_subln']) * (1.0 - lam_init)).reshape(b, s, ATTN_WIDTH)
    o_conv, conv_new = conformer_conv(c_in, conv_prev, W['w_dw'], W['b_dw'], W['g_conv_norm'], W['b_conv_norm'])
    h = h + jnp.concatenate([o_attn, o_conv.astype(o_attn.dtype)], axis=-1) @ W['w_out']
    h = h + 0.5 * swiglu(rms_norm(h, W['g_ffn2']), W['w_ffn2_gate'], W['w_ffn2_up'], W['w_ffn2_down'])
    gate = jax.nn.sigmoid(rms_norm(h, W['g_ple']) @ W['w_ple_gate'])
    h = h + (p_l @ W['w_ple_proj']) * gate
    k_rows = k.reshape(b, s, N_HEADS_ATTN, 2 * HEAD_DIM_QK)
    return h, k_rows, v, conv_new


def setup_inputs(seed: int = 0) -> dict:
    key = jax.random.key(seed)
    ks = iter(jax.random.split(key, 40))
    f32 = jnp.float32
    n_pages = PAST_LEN // PAGE_SIZE
    n_pool = (DEC_BATCH * n_pages * POOL_NUM) // POOL_DEN

    def nrm(shape, scale=1.0):
        return jax.random.normal(next(ks), shape, f32) * scale

    def gain(shape):
        return 1.0 + nrm(shape, 0.05)

    page_table = jax.random.permutation(next(ks), n_pool)[:DEC_BATCH * n_pages].reshape(DEC_BATCH, n_pages).astype(jnp.int32)
    return {
        'x_prompt': nrm((BATCH, SEQ, D_MODEL)),
        'x_sample': nrm((DEC_BATCH, DEC_SEQ, D_MODEL)),
        'cache_k': nrm((DEPTH, n_pool, PAGE_SIZE, N_HEADS_ATTN, 2 * HEAD_DIM_QK)),
        'cache_v': nrm((DEPTH, n_pool, PAGE_SIZE, N_HEADS_ATTN, HEAD_DIM_V)),
        'state_conv': nrm((DEPTH, DEC_BATCH, CONV_KERNEL - 1, CONV_WIDTH)),
        'page_table': page_table,
        'p_prompt': nrm((DEPTH, BATCH, SEQ, D_PLE)),
        'p_sample': nrm((DEPTH, DEC_BATCH, DEC_SEQ, D_PLE)),
        'g_ffn1': gain((DEPTH, D_MODEL)),
        'w_ffn1_gate': nrm((DEPTH, D_MODEL, D_FF), D_MODEL ** -0.5),
        'w_ffn1_up': nrm((DEPTH, D_MODEL, D_FF), D_MODEL ** -0.5),
        'w_ffn1_down': nrm((DEPTH, D_FF, D_MODEL), D_FF ** -0.5),
        'g_mix': gain((DEPTH, D_MODEL)),
        'w_in': nrm((DEPTH, D_MODEL, IN_COLS), D_MODEL ** -0.5),
        'lambda_q1': nrm((DEPTH, HEAD_DIM_QK), 0.1),
        'lambda_k1': nrm((DEPTH, HEAD_DIM_QK), 0.1),
        'lambda_q2': nrm((DEPTH, HEAD_DIM_QK), 0.1),
        'lambda_k2': nrm((DEPTH, HEAD_DIM_QK), 0.1),
        'g_subln': gain((DEPTH, HEAD_DIM_V)),
        'w_dw': nrm((DEPTH, CONV_KERNEL, CONV_WIDTH), CONV_KERNEL ** -0.5),
        'b_dw': nrm((DEPTH, CONV_WIDTH), 0.01),
        'g_conv_norm': gain((DEPTH, CONV_WIDTH)),
        'b_conv_norm': nrm((DEPTH, CONV_WIDTH), 0.01),
        'w_out': nrm((DEPTH, D_MODEL, D_MODEL), D_MODEL ** -0.5),
        'g_ffn2': gain((DEPTH, D_MODEL)),
        'w_ffn2_gate': nrm((DEPTH, D_MODEL, D_FF), D_MODEL ** -0.5),
        'w_ffn2_up': nrm((DEPTH, D_MODEL, D_FF), D_MODEL ** -0.5),
        'w_ffn2_down': nrm((DEPTH, D_FF, D_MODEL), D_FF ** -0.5),
        'g_ple': gain((DEPTH, D_MODEL)),
        'w_ple_gate': nrm((DEPTH, D_MODEL, D_MODEL), D_MODEL ** -0.5),
        'w_ple_proj': nrm((DEPTH, D_PLE, D_MODEL), D_PLE ** -0.5),
        'g_final': gain((D_MODEL,)),
    }


def reference(x_prompt, x_sample, cache_k, cache_v, state_conv, page_table, p_prompt, p_sample,
              g_ffn1, w_ffn1_gate, w_ffn1_up, w_ffn1_down, g_mix, w_in,
              lambda_q1, lambda_k1, lambda_q2, lambda_k2, g_subln,
              w_dw, b_dw, g_conv_norm, b_conv_norm, w_out,
              g_ffn2, w_ffn2_gate, w_ffn2_up, w_ffn2_down,
              g_ple, w_ple_gate, w_ple_proj, g_final):
    n_pages = page_table.shape[1]
    past = n_pages * PAGE_SIZE
    h_p = x_prompt
    h_s = x_sample
    kp_l, vp_l, cp_l, ks_l, vs_l, cs_l = [], [], [], [], [], []
    for l in range(DEPTH):
        W = dict(g_ffn1=g_ffn1[l], w_ffn1_gate=w_ffn1_gate[l], w_ffn1_up=w_ffn1_up[l], w_ffn1_down=w_ffn1_down[l],
                 g_mix=g_mix[l], w_in=w_in[l],
                 lambda_q1=lambda_q1[l], lambda_k1=lambda_k1[l], lambda_q2=lambda_q2[l], lambda_k2=lambda_k2[l],
                 g_subln=g_subln[l], w_dw=w_dw[l], b_dw=b_dw[l], g_conv_norm=g_conv_norm[l], b_conv_norm=b_conv_norm[l],
                 w_out=w_out[l], g_ffn2=g_ffn2[l], w_ffn2_gate=w_ffn2_gate[l], w_ffn2_up=w_ffn2_up[l],
                 w_ffn2_down=w_ffn2_down[l], g_ple=g_ple[l], w_ple_gate=w_ple_gate[l], w_ple_proj=w_ple_proj[l])
        zero_conv = jnp.zeros((h_p.shape[0], CONV_KERNEL - 1, CONV_WIDTH), h_p.dtype)
        h_p, kp, vp, cp = layer_forward(h_p, p_prompt[l], zero_conv, diff_attn_prompt, l, W)
        k_past = cache_k[l][page_table].reshape(page_table.shape[0], past, N_HEADS_ATTN, 2, HEAD_DIM_QK)
        v_past = cache_v[l][page_table].reshape(page_table.shape[0], past, N_HEADS_ATTN, HEAD_DIM_V)
        attend_s = lambda q, k, v, lam, kpst=k_past, vpst=v_past: diff_attn_sample(q, k, v, kpst, vpst, lam)
        h_s, ksn, vsn, csn = layer_forward(h_s, p_sample[l], state_conv[l], attend_s, l, W)
        kp_l.append(kp); vp_l.append(vp); cp_l.append(cp)
        ks_l.append(ksn); vs_l.append(vsn); cs_l.append(csn)
    y_prompt = rms_norm(h_p, g_final)
    y_sample = rms_norm(h_s, g_final)
    k_prompt = jnp.stack(kp_l)
    v_prompt = jnp.stack(vp_l)
    conv_prompt = jnp.stack(cp_l)
    k_sample = jnp.stack(ks_l)
    v_sample = jnp.stack(vs_l)
    conv_sample = jnp.stack(cs_l)
    return (y_prompt, y_sample, k_prompt, v_prompt, conv_prompt, k_sample, v_sample, conv_sample)
```

```cpp
#include <hip/hip_runtime.h>
#include <cstdio>
#include <cstdint>

namespace mk {
constexpr int D = 2048, FF = 5632, NIN = 5120, DPLE = 256, CW = 1024;
constexpr int MP = 8192, MS = 64, MREAL = MP + MS, MPAD = 8448;
constexpr int SEQ = 2048, NB = 4, NH = 8, DB = 8, DT = 8;
constexpr int NPAGES = 128, PAGE = 128, PAST = NPAGES * PAGE;
constexpr float LOG2E = 1.4426950408889634f;
constexpr size_t OY_P = 0, OY_S = OY_P + (size_t)MP * D, OK_P = OY_S + (size_t)MS * D, OV_P = OK_P + (size_t)MP * 1024, OC_P = OV_P + (size_t)MP * 1024,
                 OK_S = OC_P + (size_t)NB * 30 * CW, OV_S = OK_S + (size_t)MS * 1024, OC_S = OV_S + (size_t)MS * 1024, O_END = OC_S + (size_t)DB * 30 * CW;
static_assert(O_END == 34185216, "output size");
}
namespace pg8 {
#define PG8_LAS __attribute__((address_space(3)))
typedef unsigned short bf16_t;
typedef short bf16x8 __attribute__((ext_vector_type(8)));
typedef float f32x4 __attribute__((ext_vector_type(4)));
typedef unsigned u32x4 __attribute__((ext_vector_type(4)));
constexpr int BM = 256, BK = 64, HALF = 128, HTB = HALF * BK * 2  , STAGE_BYTES = 8 * HTB, NXCD = 8, WGM = 8;

__host__ __device__ __forceinline__ int lds_byte(int r, int c) { const int st = (r >> 4) * 2 + (c >> 5), rr = r & 15, cc = c & 31, ob = rr * 64 + cc * 2; return st * 1024 + (ob ^ (((ob >> 9) & 1) << 5)); }
__host__ __device__ __forceinline__ void stage_rc(int b, int& R, int& C) { const int st = b / 1024, sb = b % 1024, swz = sb ^ (((sb >> 9) & 1) << 5); R = (st >> 1) * 16 + swz / 64; C = (st & 1) * 32 + (swz % 64) / 2; }
__host__ __device__ __forceinline__ int perm32(int rho) { const int n = rho >> 4, i = rho & 15; return 8 * (i >> 2) + 4 * n + (i & 3); }

struct Unit { int pm, pn; };
struct Gemm { const bf16_t* A; const bf16_t* Bt; int M, N, K; };

struct StaticOrder {
    int nM, nN, nwg, G, c;
    __host__ __device__ void init(int M, int N, int G_, int c_) { nM = M / BM; nN = N / BM; nwg = nM * nN; G = G_; c = c_; }
    __host__ __device__ bool next(int i, Unit& u) const {
        const long L = (long)i * G + c; if (L >= nwg) return false;
        int wgid = (int)L; { const int q = nwg / NXCD, r = nwg % NXCD, xcd = wgid % NXCD, off = wgid / NXCD; wgid = (xcd < r ? xcd * (q + 1) : r * (q + 1) + (xcd - r) * q) + off; }
        const int nig = WGM * nN, gid = wgid / nig, fm = gid * WGM, gsz = (nM - fm) < WGM ? (nM - fm) : WGM;
        u.pm = fm + ((wgid % nig) % gsz); u.pn = (wgid % nig) / gsz; return true;
    }
    __device__ __forceinline__ void a_ready(const Unit&) const {}
    __device__ __forceinline__ void done(const Unit&) const {}
};

__device__ __forceinline__ unsigned cvt_pk_bf16(float lo, float hi) { unsigned r; asm volatile("v_cvt_pk_bf16_f32 %0, %1, %2" : "=v"(r) : "v"(lo), "v"(hi)); return r; }
typedef float f32x2 __attribute__((ext_vector_type(2)));
__device__ __forceinline__ float row_rstd(const float* st, int row) {
    const f32x4 a = *(const f32x4*)(st + (size_t)row * 8), b = *(const f32x4*)(st + (size_t)row * 8 + 4);
    const float s = ((a[0] + a[1]) + (a[2] + a[3])) + ((b[0] + b[1]) + (b[2] + b[3]));
    return __builtin_amdgcn_rsqf(s * (1.0f / 2048.0f) + 1e-6f);
}
__device__ __forceinline__ float sigm(float x) { return __builtin_amdgcn_rcpf(1.0f + __builtin_amdgcn_exp2f(-x * 1.4426950408889634f)); }
__device__ __forceinline__ u32x4 pack8bf(const f32x4 a, const f32x4 b) { u32x4 w; w.x = cvt_pk_bf16(a[0], a[1]); w.y = cvt_pk_bf16(a[2], a[3]); w.z = cvt_pk_bf16(b[0], b[1]); w.w = cvt_pk_bf16(b[2], b[3]); return w; }

struct EpiSwiGLU {
    static constexpr bool PERM = true, AFTER_DRAIN = false;
    bf16_t* O; const float* st; int ldo;
    __device__ __forceinline__ void operator()(const f32x4 (&acc)[2][2][4][2], const Unit& u, int wr, int wc, int fr, int fq, PG8_LAS unsigned char*, int) const {
        const int col = u.pn * 128 + wc * 32 + 8 * fq;
#pragma unroll
        for (int ai = 0; ai < 2; ++ai)
#pragma unroll
            for (int m = 0; m < 4; ++m) {
                const int row = u.pm * BM + ai * HALF + wr * 64 + m * 16 + fr;
                const float r = row_rstd(st, row);
                f32x4 v[2];
#pragma unroll
                for (int n = 0; n < 2; ++n)
#pragma unroll
                    for (int j = 0; j < 4; ++j) { const float g = acc[ai][0][m][n][j] * r, up = acc[ai][1][m][n][j] * r; v[n][j] = g * sigm(g) * up; }
                *(u32x4*)(O + (size_t)row * ldo + col) = pack8bf(v[0], v[1]);
            }
    }
};
template <int ALPHA2  > struct EpiResid {
    static constexpr bool PERM = true, AFTER_DRAIN = false;
    static constexpr float alpha = 0.5f * ALPHA2;
    const float* r0; const float* r1; int r0rows, r1end; float* H; bf16_t* Hb; float* st;
    __device__ __forceinline__ void operator()(const f32x4 (&acc)[2][2][4][2], const Unit& u, int wr, int wc, int fr, int fq, PG8_LAS unsigned char* lds, int tid) const {
        PG8_LAS float* P = (PG8_LAS float*)(lds + STAGE_BYTES);
#pragma unroll
        for (int ai = 0; ai < 2; ++ai)
#pragma unroll
            for (int m = 0; m < 4; ++m) {
                const int row = u.pm * BM + ai * HALF + wr * 64 + m * 16 + fr;
                const float* rp = row < r0rows ? r0 + (size_t)row * 2048 : (row < r1end ? r1 + (size_t)(row - r0rows) * 2048 : nullptr);
                float ss = 0.f;
#pragma unroll
                for (int bj = 0; bj < 2; ++bj) {
                    const int col = u.pn * BM + bj * HALF + wc * 32 + 8 * fq;
                    f32x4 x0 = (f32x4){0.f, 0.f, 0.f, 0.f}, x1 = x0;
                    if (rp) { x0 = *(const f32x4*)(rp + col); x1 = *(const f32x4*)(rp + col + 4); }
                    const f32x4 v0 = x0 + acc[ai][bj][m][0] * alpha, v1 = x1 + acc[ai][bj][m][1] * alpha;
                    *(f32x4*)(H + (size_t)row * 2048 + col) = v0; *(f32x4*)(H + (size_t)row * 2048 + col + 4) = v1;
                    *(u32x4*)(Hb + (size_t)row * 2048 + col) = pack8bf(v0, v1);
                    ss += ((v0[0] * v0[0] + v0[1] * v0[1]) + (v0[2] * v0[2] + v0[3] * v0[3])) + ((v1[0] * v1[0] + v1[1] * v1[1]) + (v1[2] * v1[2] + v1[3] * v1[3]));
                }
                ss += __shfl_xor(ss, 16); ss += __shfl_xor(ss, 32);
                if (fq == 0) P[(ai * HALF + wr * 64 + m * 16 + fr) * 4 + wc] = ss;
            }
        asm volatile("s_waitcnt lgkmcnt(0)" ::: "memory"); __builtin_amdgcn_s_barrier(); asm volatile("" ::: "memory");
        if (tid < 256) { const f32x4 p = *(const PG8_LAS f32x4*)(P + tid * 4); st[(size_t)(u.pm * BM + tid) * 8 + u.pn] = (p[0] + p[1]) + (p[2] + p[3]); }
    }
};
struct EpiWin {
    static constexpr bool PERM = true, AFTER_DRAIN = false;
    const float* st; bf16_t* Q; size_t qkv_stride; float* U; float* out;
    __device__ __forceinline__ void operator()(const f32x4 (&acc)[2][2][4][2], const Unit& u, int wr, int wc, int fr, int fq, PG8_LAS unsigned char*, int) const {
        const int pn = u.pn;
#pragma unroll
        for (int ai = 0; ai < 2; ++ai)
#pragma unroll
            for (int m = 0; m < 4; ++m) {
                const int row = u.pm * BM + ai * HALF + wr * 64 + m * 16 + fr;
                const float r = row_rstd(st, row);
                if (pn < 12) {
                    bf16_t* dst = Q + (size_t)(pn >> 2) * qkv_stride;
                    float* fo = nullptr;
                    if (pn >= 4 && row < mk::MREAL) {
                        const size_t kv = (size_t)((pn >> 2) - 1);
                        fo = row < mk::MP ? out + mk::OK_P + kv * ((size_t)mk::MP * 1024) + (size_t)row * 1024 : out + mk::OK_S + kv * ((size_t)mk::MS * 1024) + (size_t)(row - mk::MP) * 1024;
                    }
#pragma unroll
                    for (int bj = 0; bj < 2; ++bj) {
                        const int col = (pn & 3) * 256 + bj * HALF + wc * 32 + 8 * fq;
                        const f32x4 v0 = acc[ai][bj][m][0] * r, v1 = acc[ai][bj][m][1] * r;
                        *(u32x4*)(dst + (size_t)row * 1024 + col) = pack8bf(v0, v1);
                        if (fo) { *(f32x4*)(fo + col) = v0; *(f32x4*)(fo + col + 4) = v1; }
                    }
                } else {
                    const int col = (pn - 12) * 128 + wc * 32 + 8 * fq;
                    f32x4 v[2];
#pragma unroll
                    for (int n = 0; n < 2; ++n)
#pragma unroll
                        for (int j = 0; j < 4; ++j) { const float a = acc[ai][0][m][n][j] * r, g = acc[ai][1][m][n][j] * r; v[n][j] = a * sigm(g); }
                    *(f32x4*)(U + (size_t)row * 1024 + col) = v[0]; *(f32x4*)(U + (size_t)row * 1024 + col + 4) = v[1];
                    float* co = nullptr;
                    if (row < mk::MP) { const int tt = row & 2047; if (tt >= 2018) co = out + mk::OC_P + (size_t)((row >> 11) * 30 + (tt - 2018)) * 1024; }
                    else if (row < mk::MREAL) { const int rs = row - mk::MP; co = out + mk::OC_S + (size_t)((rs >> 3) * 30 + 22 + (rs & 7)) * 1024; }
                    if (co) { *(f32x4*)(co + col) = v[0]; *(f32x4*)(co + col + 4) = v[1]; }
                }
            }
    }
};
struct EpiPle {
    static constexpr bool PERM = true, AFTER_DRAIN = false;
    const float* st; const float* H3; const float* PJ; float* H4;
    __device__ __forceinline__ void operator()(const f32x4 (&acc)[2][2][4][2], const Unit& u, int wr, int wc, int fr, int fq, PG8_LAS unsigned char*, int) const {
#pragma unroll
        for (int ai = 0; ai < 2; ++ai)
#pragma unroll
            for (int m = 0; m < 4; ++m) {
                const int row = u.pm * BM + ai * HALF + wr * 64 + m * 16 + fr;
                const float r = row_rstd(st, row);
#pragma unroll
                for (int bj = 0; bj < 2; ++bj) {
                    const size_t off = (size_t)row * 2048 + u.pn * BM + bj * HALF + wc * 32 + 8 * fq;
#pragma unroll
                    for (int n = 0; n < 2; ++n) {
                        const f32x4 h3 = *(const f32x4*)(H3 + off + 4 * n), pj = *(const f32x4*)(PJ + off + 4 * n); f32x4 o;
#pragma unroll
                        for (int j = 0; j < 4; ++j) o[j] = h3[j] + pj[j] * sigm(acc[ai][bj][m][n][j] * r);
                        *(f32x4*)(H4 + off + 4 * n) = o;
                    }
                }
            }
    }
};
struct EpiF32 {
    static constexpr bool PERM = true, AFTER_DRAIN = false;
    float* O;
    __device__ __forceinline__ void operator()(const f32x4 (&acc)[2][2][4][2], const Unit& u, int wr, int wc, int fr, int fq, PG8_LAS unsigned char*, int) const {
#pragma unroll
        for (int ai = 0; ai < 2; ++ai)
#pragma unroll
            for (int m = 0; m < 4; ++m) {
                const int row = u.pm * BM + ai * HALF + wr * 64 + m * 16 + fr;
#pragma unroll
                for (int bj = 0; bj < 2; ++bj) {
                    const size_t off = (size_t)row * 2048 + u.pn * BM + bj * HALF + wc * 32 + 8 * fq;
                    *(f32x4*)(O + off) = acc[ai][bj][m][0]; *(f32x4*)(O + off + 4) = acc[ai][bj][m][1];
                }
            }
    }
};
template <class Epi, class Sched, bool ALIGN_EPI = false, bool SP2 = false>
__device__ __forceinline__ void gemm_phase(PG8_LAS unsigned char* lds, const Gemm g, const Sched& S, const Epi& E) {
    int tid_l = threadIdx.x; asm volatile("" : "+v"(tid_l));
    const int tid = tid_l, wid = __builtin_amdgcn_readfirstlane(tid >> 6), lane = tid & 63, wr = wid >> 2, wc = wid & 3, fr = lane & 15, fq = lane >> 4;
    const int K = g.K, nt = K / BK;
    unsigned voffA[2], voffB[2];
#pragma unroll
    for (int i = 0; i < 2; ++i) { int R, C; stage_rc(tid * 16 + i * 8192, R, C); const int Rb = Epi::PERM ? ((R & ~31) + perm32(R & 31)) : R;
        voffA[i] = (unsigned)(R * K + C) * 2u; voffB[i] = (unsigned)(Rb * K + C) * 2u; }
    const size_t kstep = (size_t)(BK * 2);
    const size_t hstep = (size_t)HALF * K * 2;
    const size_t tstep = 2 * hstep;
    const unsigned ldsw = (unsigned)wid * 1024u;
    const int aoff = lds_byte(wr * 64 + fr, fq * 8), boff = lds_byte(wc * 32 + fr, fq * 8);
#define PG8_SA(b, h) (((b) * 2 + (h)) * HTB)
#define PG8_SB(b, h) ((4 + (b) * 2 + (h)) * HTB)
#define PG8_STAGE(bufoff, gbase, voff) do { _Pragma("unroll") for (int _i = 0; _i < 2; ++_i) \
        __builtin_amdgcn_global_load_lds((const unsigned*)((const char*)(gbase) + (voff)[_i]), (PG8_LAS unsigned*)(lds + (bufoff) + ldsw + _i * 8192), 16, 0, 0); } while (0)
#define PG8_LDA(dst, b, h) do { _Pragma("unroll") for (int m = 0; m < 4; ++m) _Pragma("unroll") for (int k = 0; k < 2; ++k) dst[m][k] = *(const PG8_LAS bf16x8*)(lds + PG8_SA(b, h) + aoff + m * 2048 + k * 1024); } while (0)
#define PG8_LDB(dst, b, h) do { _Pragma("unroll") for (int n = 0; n < 2; ++n) _Pragma("unroll") for (int k = 0; k < 2; ++k) dst[n][k] = *(const PG8_LAS bf16x8*)(lds + PG8_SB(b, h) + boff + n * 2048 + k * 1024); } while (0)
#define PG8_MMA(ai, bj, At, Bt) do { __builtin_amdgcn_s_setprio(1); _Pragma("unroll") for (int m = 0; m < 4; ++m) _Pragma("unroll") for (int n = 0; n < 2; ++n) _Pragma("unroll") for (int k = 0; k < 2; ++k) \
        acc[ai][bj][m][n] = __builtin_amdgcn_mfma_f32_16x16x32_bf16(Bt[n][k], At[m][k], acc[ai][bj][m][n], 0, 0, 0); __builtin_amdgcn_s_setprio(0); } while (0)
#define PG8_WAIT_V(n) asm volatile("s_waitcnt vmcnt(" #n ")" ::: "memory")
#define PG8_WAIT_L(n) asm volatile("s_waitcnt lgkmcnt(" #n ")" ::: "memory")
#define PG8_BAR __builtin_amdgcn_s_barrier()
#define PG8_SCHED __builtin_amdgcn_sched_barrier(0)
    Unit cur, nxt; int ui = 0;
    if (!S.next(0, cur)) return;
    f32x4 acc[2][2][4][2];
#pragma unroll
    for (int a = 0; a < 2; ++a)
#pragma unroll
        for (int b = 0; b < 2; ++b)
#pragma unroll
            for (int m = 0; m < 4; ++m)
#pragma unroll
                for (int n = 0; n < 2; ++n) acc[a][b][m][n] = (f32x4){0.f, 0.f, 0.f, 0.f};
    bf16x8 At[4][2], B0[2][2], B1[2][2];
    const char* cA = (const char*)g.A + (size_t)cur.pm * tstep; const char* cB = (const char*)g.Bt + (size_t)cur.pn * tstep;
    S.a_ready(cur);
    if constexpr (SP2) {
        PG8_STAGE(PG8_SB(0, 0), cB, voffB); PG8_STAGE(PG8_SB(0, 1), cB + hstep, voffB); PG8_STAGE(PG8_SA(0, 0), cA, voffA); PG8_STAGE(PG8_SA(0, 1), cA + hstep, voffA);
        if (wr == 1) PG8_BAR;
        PG8_WAIT_V(2); PG8_BAR;
        PG8_STAGE(PG8_SB(1, 0), cB + kstep, voffB); PG8_STAGE(PG8_SA(1, 0), cA + kstep, voffA); PG8_STAGE(PG8_SB(1, 1), cB + hstep + kstep, voffB);
        PG8_WAIT_V(6); PG8_BAR;
    } else {
        PG8_STAGE(PG8_SB(0, 0), cB, voffB); PG8_STAGE(PG8_SA(0, 0), cA, voffA); PG8_STAGE(PG8_SB(0, 1), cB + hstep, voffB); PG8_STAGE(PG8_SA(0, 1), cA + hstep, voffA);
        if (wr == 1) PG8_BAR;
        PG8_WAIT_V(4); PG8_BAR;
        PG8_STAGE(PG8_SB(1, 0), cB + kstep, voffB); PG8_STAGE(PG8_SA(1, 0), cA + kstep, voffA); PG8_STAGE(PG8_SB(1, 1), cB + hstep + kstep, voffB);
        PG8_WAIT_V(6); PG8_BAR;
    }
    for (;;) {
        const bool has_next = S.next(ui + 1, nxt);
        const char* nA = has_next ? (const char*)g.A + (size_t)nxt.pm * tstep : cA; const char* nB = has_next ? (const char*)g.Bt + (size_t)nxt.pn * tstep : cB;
        for (int t = 0; t < nt; t += 2) {
            const bool last = (t == nt - 2);
            const char* a1 = cA + (size_t)(t + 1) * kstep;
            const char* a2 = last ? nA : cA + (size_t)(t + 2) * kstep; const char* b2 = last ? nB : cB + (size_t)(t + 2) * kstep;
            const char* a3 = a2 + kstep; const char* b3 = b2 + kstep;
            if (last && has_next) S.a_ready(nxt);
            if constexpr (SP2) {
            PG8_LDB(B0, 0, 0); PG8_LDB(B1, 0, 1); PG8_SCHED; PG8_LDA(At, 0, 0); PG8_STAGE(PG8_SA(1, 1), a1 + hstep, voffA);
            PG8_WAIT_V(8); PG8_WAIT_L(0); PG8_BAR; PG8_MMA(0, 0, At, B0); PG8_MMA(0, 1, At, B1); PG8_BAR; PG8_SCHED;
            PG8_LDA(At, 0, 1); PG8_STAGE(PG8_SB(0, 0), b2, voffB); PG8_STAGE(PG8_SB(0, 1), b2 + hstep, voffB); PG8_STAGE(PG8_SA(0, 0), a2, voffA);
            PG8_WAIT_V(8); PG8_WAIT_L(0); PG8_BAR; PG8_MMA(1, 0, At, B0); PG8_MMA(1, 1, At, B1); PG8_BAR; PG8_SCHED;
            PG8_LDB(B0, 1, 0); PG8_LDB(B1, 1, 1); PG8_SCHED; PG8_LDA(At, 1, 0); PG8_STAGE(PG8_SA(0, 1), a2 + hstep, voffA);
            PG8_WAIT_V(8); PG8_WAIT_L(0); PG8_BAR; PG8_MMA(0, 0, At, B0); PG8_MMA(0, 1, At, B1); PG8_BAR; PG8_SCHED;
            PG8_LDA(At, 1, 1); PG8_STAGE(PG8_SB(1, 0), b3, voffB); PG8_STAGE(PG8_SB(1, 1), b3 + hstep, voffB); PG8_STAGE(PG8_SA(1, 0), a3, voffA);
            PG8_WAIT_V(8); PG8_WAIT_L(0); PG8_BAR; PG8_MMA(1, 0, At, B0); PG8_MMA(1, 1, At, B1); PG8_BAR; PG8_SCHED;
            } else {
            PG8_LDB(B0, 0, 0); PG8_SCHED; PG8_LDA(At, 0, 0); PG8_STAGE(PG8_SA(1, 1), a1 + hstep, voffA);
            PG8_WAIT_L(8); PG8_BAR; PG8_WAIT_L(0); PG8_MMA(0, 0, At, B0); PG8_BAR; PG8_SCHED;
            PG8_LDB(B1, 0, 1); PG8_STAGE(PG8_SB(0, 0), b2, voffB);
            PG8_BAR; PG8_WAIT_L(0); PG8_MMA(0, 1, At, B1); PG8_BAR;
            PG8_LDA(At, 0, 1); PG8_STAGE(PG8_SA(0, 0), a2, voffA);
            PG8_BAR; PG8_WAIT_L(0); PG8_MMA(1, 0, At, B0); PG8_BAR; PG8_SCHED;
            PG8_STAGE(PG8_SB(0, 1), b2 + hstep, voffB);
            PG8_WAIT_V(6); PG8_BAR; PG8_MMA(1, 1, At, B1); PG8_BAR;
            PG8_LDB(B0, 1, 0); PG8_SCHED; PG8_LDA(At, 1, 0); PG8_STAGE(PG8_SA(0, 1), a2 + hstep, voffA);
            PG8_WAIT_L(8); PG8_BAR; PG8_WAIT_L(0); PG8_MMA(0, 0, At, B0); PG8_BAR; PG8_SCHED;
            PG8_LDB(B1, 1, 1); PG8_STAGE(PG8_SB(1, 0), b3, voffB);
            PG8_BAR; PG8_WAIT_L(0); PG8_MMA(0, 1, At, B1); PG8_BAR;
            PG8_LDA(At, 1, 1); PG8_STAGE(PG8_SA(1, 0), a3, voffA);
            PG8_BAR; PG8_WAIT_L(0); PG8_MMA(1, 0, At, B0); PG8_BAR; PG8_SCHED;
            PG8_STAGE(PG8_SB(1, 1), b3 + hstep, voffB);
            PG8_WAIT_V(6); PG8_BAR; PG8_MMA(1, 1, At, B1); PG8_BAR;
            }
        }
        if constexpr (ALIGN_EPI) { if (wr == 0) PG8_BAR; }
        if constexpr (!Epi::AFTER_DRAIN) { E(acc, cur, wr, wc, fr, fq, lds, tid); S.done(cur); }
        if (!has_next) break;
#pragma unroll
        for (int a = 0; a < 2; ++a)
#pragma unroll
            for (int b = 0; b < 2; ++b)
#pragma unroll
                for (int m = 0; m < 4; ++m)
#pragma unroll
                    for (int n = 0; n < 2; ++n) acc[a][b][m][n] = (f32x4){0.f, 0.f, 0.f, 0.f};
        cur = nxt; cA = nA; cB = nB; ++ui;
        if constexpr (ALIGN_EPI) { if (wr == 1) PG8_BAR; }
    }
    PG8_WAIT_V(0);
    if constexpr (!ALIGN_EPI) { if (wr == 0) PG8_BAR; }
    PG8_BAR;
    if constexpr (Epi::AFTER_DRAIN) { E.fused(acc, cur, wr, wc, fr, fq, lds, wid, lane); S.done(cur); }
#undef PG8_SA
#undef PG8_SB
#undef PG8_STAGE
#undef PG8_LDA
#undef PG8_LDB
#undef PG8_MMA
#undef PG8_WAIT_V
#undef PG8_WAIT_L
#undef PG8_BAR
#undef PG8_SCHED
}
}
#define GAS __attribute__((address_space(1)))
#define LAS __attribute__((address_space(3)))
typedef unsigned short bf16;
typedef unsigned v4u __attribute__((ext_vector_type(4)));
typedef float f32x4 __attribute__((ext_vector_type(4)));
typedef short bf16x8 __attribute__((ext_vector_type(8)));
typedef GAS unsigned gu32;
typedef GAS unsigned long long gu64;
#define RLX_AGENT __ATOMIC_RELAXED, __HIP_MEMORY_SCOPE_AGENT
#define LDS_WAIT() asm volatile("s_waitcnt lgkmcnt(0)" ::: "memory")
#define VM_WAIT() asm volatile("s_waitcnt vmcnt(0)" ::: "memory")
__device__ __forceinline__ unsigned long long rt() { return __builtin_amdgcn_s_memrealtime(); }
__device__ __forceinline__ unsigned f2bf(float f) { unsigned u = __builtin_bit_cast(unsigned, f); return (u + 0x7fffu + ((u >> 16) & 1u)) >> 16; }
__device__ __forceinline__ unsigned pk2(float lo, float hi) { return f2bf(lo) | (f2bf(hi) << 16); }

#define XB_TMO      128
#define XB_XCNT(j)  (256  + 64 * (j))
#define XB_XSUB(j)  (1280 + 64 * (j))
#define XB_XGEN(j)  (2304 + 64 * (j))
#define XB_TOP      3328
#define XB_TOPGEN   3392
#define XCD_BAR_WORDS 3456
#define XB_SPIN_CAP (1u << 18)

__device__ __forceinline__ unsigned xb_ld(unsigned* p)              { return __hip_atomic_load(p, __ATOMIC_RELAXED, __HIP_MEMORY_SCOPE_AGENT); }
__device__ __forceinline__ unsigned xb_add(unsigned* p, unsigned v) { return __hip_atomic_fetch_add(p, v, __ATOMIC_RELAXED, __HIP_MEMORY_SCOPE_AGENT); }
__device__ __forceinline__ unsigned xb_xcc_id() { return (unsigned)__builtin_amdgcn_s_getreg((3 << 11) | 20) & 0xFu; }
#define XB_SPIN(cond, bar) do { unsigned _sp = 0; while (cond) { __builtin_amdgcn_s_sleep(1); \
    if ((++_sp & 255u) == 0u) { if (xb_ld(&(bar)[XB_TMO])) break; if (_sp > XB_SPIN_CAP) { atomicAdd(&(bar)[XB_TMO], 1u); break; } } } } while (0)

struct XcdBarrier {
    unsigned* bar; unsigned x;
    volatile LAS unsigned* st;
};

__device__ __forceinline__ XcdBarrier xcd_barrier_post(unsigned* bar, volatile LAS unsigned* st) {
    XcdBarrier b; b.bar = bar; b.x = xb_xcc_id(); b.st = st;
    if (threadIdx.x == 0) (void)xb_add(&bar[XB_XCNT(b.x)], 1u);
    return b;
}
__device__ __forceinline__ void xcd_barrier_complete(unsigned* bar, unsigned x, unsigned& nloc, unsigned& nx) {
    const unsigned G = gridDim.x * gridDim.y * gridDim.z;
    unsigned sum, cnt, mine, sp = 0u;
    for (;;) {
        sum = 0u; cnt = 0u; mine = 0u;
#pragma unroll
        for (unsigned j = 0; j < 16; ++j) { const unsigned c = xb_ld(&bar[XB_XCNT(j)]); sum += c; cnt += (c > 0u) ? 1u : 0u; mine = (j == x) ? c : mine; }
        if (sum == G) break;
        __builtin_amdgcn_s_sleep(1);
        if ((++sp & 255u) == 0u) { if (xb_ld(&bar[XB_TMO])) break; if (sp > XB_SPIN_CAP) { atomicAdd(&bar[XB_TMO], 1u); break; } }
    }
    nloc = mine > 0u ? mine : 1u; nx = cnt > 0u ? cnt : 1u;
}

__device__ __forceinline__ void xcd_barrier(const XcdBarrier& b) {
    asm volatile("s_waitcnt vmcnt(0)" ::: "memory");
    __syncthreads();
    if (threadIdx.x == 0) {
        unsigned* bar = b.bar;
        __builtin_amdgcn_s_waitcnt(0);
        unsigned nloc = b.st[0], nx = b.st[1];
        if (nloc == 0u) { xcd_barrier_complete(bar, b.x, nloc, nx); b.st[0] = nloc; b.st[1] = nx; }
        const unsigned old = xb_add(&bar[XB_XSUB(b.x)], 1u);
        const unsigned gen = old / nloc;
        if (old + 1u == (gen + 1u) * nloc) {
            __builtin_amdgcn_fence(__ATOMIC_RELEASE, "agent");
            asm volatile("s_waitcnt vmcnt(0)" ::: "memory");
            const unsigned og = xb_add(&bar[XB_TOP], 1u);
            const unsigned tg = og / nx;
            if (og + 1u == (tg + 1u) * nx) xb_add(&bar[XB_TOPGEN], 1u);
            else XB_SPIN(xb_ld(&bar[XB_TOPGEN]) == tg, bar);
            __builtin_amdgcn_fence(__ATOMIC_ACQUIRE, "agent");
            xb_add(&bar[XB_XGEN(b.x)], 1u);
            asm volatile("s_waitcnt vmcnt(0)" ::: "memory");
        } else {
            XB_SPIN(xb_ld(&bar[XB_XGEN(b.x)]) == gen, bar);
            __builtin_amdgcn_fence(__ATOMIC_ACQUIRE, "agent");
            asm volatile("s_waitcnt vmcnt(0)" ::: "memory");
        }
    }
    __syncthreads();
}
namespace att {
typedef short bf16x8 __attribute__((ext_vector_type(8)));
typedef short s16x4 __attribute__((ext_vector_type(4)));
typedef float f32x16 __attribute__((ext_vector_type(16)));
typedef float f32x4 __attribute__((ext_vector_type(4)));
typedef unsigned u32x4 __attribute__((ext_vector_type(4)));
typedef unsigned short bf16_t;
constexpr int KVBLK = 64, QBLK = 32;
constexpr int SHM_V = KVBLK * 128 * 2, SHM_K = KVBLK * 128 * 2;
constexpr float SCALE = 0.125f, THR = 8.f;
#define KSWZ(row, colB) ((row) * 256 + ((colB) ^ (((row) & 7) << 4)))
#define SBAR() __builtin_amdgcn_sched_barrier(0)
__device__ __forceinline__ int v_st(int k, int c) { const int kk = (k & ~0xC) | ((k & 4) << 1) | ((k & 8) >> 1); return ((kk >> 3) * 4 + (c >> 5)) * 512 + ((kk & 7) * 32 + (c & 31)) * 2; }
__device__ __forceinline__ int v_rd_base(int lane) { return ((lane & 3) << 3) | (((lane >> 2) & 3) << 6) | (((lane >> 4) & 1) << 5) | (((lane >> 5) & 1) << 8); }
constexpr int v_rd_off(int d0, int ks, int half) { return d0 * 512 + ks * 4096 + half * 2048; }
__device__ __forceinline__ int crow(int r, int hi) { return (r & 3) + 8 * (r >> 2) + 4 * hi; }
__device__ __forceinline__ unsigned cvtpk(float lo, float hi) { unsigned r; asm volatile("v_cvt_pk_bf16_f32 %0, %1, %2" : "=v"(r) : "v"(lo), "v"(hi)); return r; }
__device__ __forceinline__ float bf2f(bf16_t x) { return __uint_as_float((unsigned)x << 16); }
__device__ __forceinline__ void mask_tile(f32x16& p0, f32x16& p1, int dq) {
    const float NEG = -__builtin_inff();
#pragma unroll
    for (int r = 0; r < 16; ++r) {
        const int c = (r & 3) + 8 * (r >> 2);
        if (dq - c < 0) p0[r] = NEG;
        if (dq - c - 32 < 0) p1[r] = NEG;
    }
}
__device__ __forceinline__ void partialSM(f32x16& p0, f32x16& p1, float& m_reg, float& mn, float& alpha) {
    float pmax = p0[0];
#pragma unroll
    for (int r = 1; r < 16; ++r) pmax = fmaxf(pmax, p0[r]);
#pragma unroll
    for (int r = 0; r < 16; ++r) pmax = fmaxf(pmax, p1[r]);
    { auto rr = __builtin_amdgcn_permlane32_swap(__float_as_uint(pmax), __float_as_uint(pmax), false, false);
      pmax = fmaxf(__uint_as_float(rr[0]), __uint_as_float(rr[1])); }
    constexpr float C2 = 1.4426950408889634f * SCALE;
    if (__builtin_expect(__all((pmax - m_reg) * SCALE <= THR), 1)) { mn = m_reg; alpha = 1.f; }
    else { mn = fmaxf(m_reg, pmax); alpha = __builtin_amdgcn_exp2f((m_reg - mn) * C2); m_reg = mn; }
    const float mnL = -mn * C2;
#pragma unroll
    for (int r = 0; r < 16; ++r) p0[r] = fmaf(p0[r], C2, mnL);
#pragma unroll
    for (int r = 0; r < 16; ++r) p1[r] = fmaf(p1[r], C2, mnL);
#pragma unroll
    for (int r = 0; r < 16; ++r) p0[r] = __builtin_amdgcn_exp2f(p0[r]);
}
__device__ __forceinline__ void finishSM(f32x16& p0, f32x16& p1, float alpha, float& l_reg, bf16x8& pa0, bf16x8& pa1, bf16x8& pa2, bf16x8& pa3) {
#pragma unroll
    for (int r = 0; r < 16; ++r) p1[r] = __builtin_amdgcn_exp2f(p1[r]);
    float ps = 0;
#pragma unroll
    for (int r = 0; r < 16; ++r) ps += p0[r];
#pragma unroll
    for (int r = 0; r < 16; ++r) ps += p1[r];
    { auto rr = __builtin_amdgcn_permlane32_swap(__float_as_uint(ps), __float_as_uint(ps), false, false);
      ps = __uint_as_float(rr[0]) + __uint_as_float(rr[1]); }
    l_reg = l_reg * alpha + ps;
#define PK4(P, B_, OUT) do { unsigned a0 = cvtpk(P[B_+0], P[B_+1]), a1 = cvtpk(P[B_+2], P[B_+3]);                          \
        unsigned b0 = cvtpk(P[B_+4], P[B_+5]), b1 = cvtpk(P[B_+6], P[B_+7]);                                             \
        auto r0 = __builtin_amdgcn_permlane32_swap(a0, b0, false, false); auto r1 = __builtin_amdgcn_permlane32_swap(a1, b1, false, false); \
        u32x4 w = {r0[0], r1[0], r0[1], r1[1]}; OUT = *reinterpret_cast<bf16x8*>(&w); } while (0)
    PK4(p0, 0, pa0); PK4(p0, 8, pa1); PK4(p1, 0, pa2); PK4(p1, 8, pa3);
#undef PK4
}
template <int KB>
__device__ __forceinline__ void qkt(f32x16& p0, f32x16& p1, const char* K_lds, int r32, int hi, int moff, const bf16x8* qr, const f32x16& cb, float t0, float t1) {
#pragma unroll
    for (int r = 0; r < 16; ++r) { p0[r] = cb[r] + t0; p1[r] = cb[r] + t1; }
    const char* kb[4];
#pragma unroll
    for (int dd = 0; dd < 4; ++dd) kb[dd] = K_lds + KB * SHM_K + KSWZ(r32, (dd * 16 + hi * 8) * 2) + moff;
#pragma unroll
    for (int d0 = 0; d0 < 4; ++d0) {
        bf16x8 b0 = *reinterpret_cast<const bf16x8*>(kb[d0]);
        bf16x8 b1 = *reinterpret_cast<const bf16x8*>(kb[d0] + 32 * 256);
        p0 = __builtin_amdgcn_mfma_f32_32x32x16_bf16(b0, qr[d0], p0, 0, 0, 0);
        p1 = __builtin_amdgcn_mfma_f32_32x32x16_bf16(b1, qr[d0], p1, 0, 0, 0); }
}
template <int VB>
__device__ __forceinline__ void pv_tile(f32x16* o, int vb0, bf16x8 pa0, bf16x8 pa1, bf16x8 pa2, bf16x8 pa3) {
#define TRRD(dst, off) asm volatile("ds_read_b64_tr_b16 %0, %1 offset:%2" : "=&v"(dst) : "v"(vb0), "i"(off) : "memory")
#define PV_D0(d0) do { s16x4 l0, l1, l2, l3, h0, h1, h2, h3; constexpr int b_ = VB * SHM_V + v_rd_off(d0, 0, 0); \
        TRRD(l0, b_); TRRD(h0, b_ + 2048); TRRD(l1, b_ + 4096); TRRD(h1, b_ + 6144); TRRD(l2, b_ + 8192); TRRD(h2, b_ + 10240); TRRD(l3, b_ + 12288); TRRD(h3, b_ + 14336); \
        asm volatile("s_waitcnt lgkmcnt(0)" ::: "memory"); SBAR();   \
        o[d0] = __builtin_amdgcn_mfma_f32_32x32x16_bf16(pa0, (bf16x8){l0[0], l0[1], l0[2], l0[3], h0[0], h0[1], h0[2], h0[3]}, o[d0], 0, 0, 0);   \
        o[d0] = __builtin_amdgcn_mfma_f32_32x32x16_bf16(pa1, (bf16x8){l1[0], l1[1], l1[2], l1[3], h1[0], h1[1], h1[2], h1[3]}, o[d0], 0, 0, 0);   \
        o[d0] = __builtin_amdgcn_mfma_f32_32x32x16_bf16(pa2, (bf16x8){l2[0], l2[1], l2[2], l2[3], h2[0], h2[1], h2[2], h2[3]}, o[d0], 0, 0, 0);   \
        o[d0] = __builtin_amdgcn_mfma_f32_32x32x16_bf16(pa3, (bf16x8){l3[0], l3[1], l3[2], l3[3], h3[0], h3[1], h3[2], h3[3]}, o[d0], 0, 0, 0); } while (0)
    PV_D0(0); PV_D0(1); PV_D0(2); PV_D0(3);
#undef PV_D0
#undef TRRD
}
#define VMW() asm volatile("s_waitcnt vmcnt(0)" ::: "memory")
__device__ __forceinline__ void attn_block(const bf16_t* QB, const bf16_t* KBp, const bf16_t* VBp, bf16_t* AO, int seq0, int P0, int h, float c1, float lam, const float* gsub, char* lds) {
    int tid_l = threadIdx.x; asm volatile("" : "+v"(tid_l));
    const int tid = tid_l, wid = __builtin_amdgcn_readfirstlane(tid >> 6), lane = tid & 63, r32 = lane & 31, hi = lane >> 5;
    const int mp = wid & 1, rg = wid >> 1;
    const int NT = (P0 + 128) / KVBLK;
    const int qlo = P0 + rg * QBLK, qm = qlo + r32 - 4 * hi;
    char* V_lds = lds; char* K_lds = lds + 2 * SHM_V;
    float* ws = (float*)(lds + 2 * SHM_V + 2 * SHM_K) + wid * 64; float* li_l = ws, * al_l = ws + 32;
    const int sr = tid >> 4, sc = (tid & 15) * 8, vst0 = v_st(sr, sc), vst1 = v_st(32 + sr, sc), kws = KSWZ(sr, sc * 2);
    const int vb0 = (int)(uintptr_t)V_lds + v_rd_base(lane);
    const bf16_t* Kh = KBp + (size_t)seq0 * 1024 + h * 128 + sc; const bf16_t* Vh = VBp + (size_t)seq0 * 1024 + h * 128 + sc;
    bf16x8 qr[4];
#pragma unroll
    for (int d0 = 0; d0 < 4; ++d0) qr[d0] = *reinterpret_cast<const bf16x8*>(QB + (size_t)(seq0 + qlo + r32) * 1024 + h * 128 + mp * 64 + d0 * 16 + hi * 8);
    f32x16 cb;
#pragma unroll
    for (int r = 0; r < 16; ++r) cb[r] = c1 * (float)crow(r, hi);
    const int moff = mp * 128;
    bf16x8 st_v0, st_v1, st_k0, st_k1;
#define SLOAD(k0) do { st_v0 = *reinterpret_cast<const bf16x8*>(Vh + (size_t)((k0) + sr) * 1024); st_v1 = *reinterpret_cast<const bf16x8*>(Vh + (size_t)((k0) + 32 + sr) * 1024); \
                       st_k0 = *reinterpret_cast<const bf16x8*>(Kh + (size_t)((k0) + sr) * 1024); st_k1 = *reinterpret_cast<const bf16x8*>(Kh + (size_t)((k0) + 32 + sr) * 1024); } while (0)
#define SWRITE(bf) do { *(bf16x8*)(V_lds + (bf) * SHM_V + vst0) = st_v0; *(bf16x8*)(V_lds + (bf) * SHM_V + vst1) = st_v1; \
                        *(bf16x8*)(K_lds + (bf) * SHM_K + kws) = st_k0; *(bf16x8*)(K_lds + (bf) * SHM_K + kws + 32 * 256) = st_k1; } while (0)
#define TB0(t) (c1 * (float)((t) * KVBLK - P0))
#define MASKT(P0_, P1_, t) do { const int kb_ = (t) * KVBLK; if (kb_ + KVBLK - 1 > qlo) mask_tile(P0_, P1_, qm - kb_); } while (0)
#define RESC(a) do { if (__any((a) < 1.f)) { if (hi == 0) al_l[r32] = (a); asm volatile("s_waitcnt lgkmcnt(0)" ::: "memory");              \
                     _Pragma("unroll") for (int d_ = 0; d_ < 4; ++d_) _Pragma("unroll") for (int r = 0; r < 16; ++r) o[d_][r] *= al_l[crow(r, hi)]; } } while (0)
    float m_reg = -1e30f, l_reg = 0; f32x16 o[4] = {};
    f32x16 pA0, pA1, pB0, pB1; float mnA, mnB, alA, alB; bf16x8 pa0, pa1, pa2, pa3;
    SLOAD(0); VMW(); SWRITE(0); SBAR();
    SLOAD(KVBLK);
    __syncthreads();
    { const float t0 = TB0(0); qkt<0>(pA0, pA1, K_lds, r32, hi, moff, qr, cb, t0, t0 + 32.f * c1); }
    MASKT(pA0, pA1, 0); partialSM(pA0, pA1, m_reg, mnA, alA);
    VMW(); SWRITE(1);
    __syncthreads();
#define HALF_STEP(PX0, PX1, mnX, alX, PY0, PY1, alY, t, KB, VB, SB) do {                                                      \
        SBAR(); { const float t0 = TB0(t); qkt<KB>(PX0, PX1, K_lds, r32, hi, moff, qr, cb, t0, t0 + 32.f * c1); }              \
        finishSM(PY0, PY1, alY, l_reg, pa0, pa1, pa2, pa3); SBAR();                                                           \
        if ((t) + 1 < NT) { SLOAD(((t) + 1) * KVBLK); SBAR(); }                                                               \
        pv_tile<VB>(o, vb0, pa0, pa1, pa2, pa3); MASKT(PX0, PX1, (t)); partialSM(PX0, PX1, m_reg, mnX, alX);                  \
        __syncthreads();                                                                                                      \
        if ((t) + 1 < NT) { VMW(); SWRITE(SB); }                                                                              \
        RESC(alX); __syncthreads(); } while (0)
    for (int t = 1; t + 1 < NT; t += 2) {
        HALF_STEP(pB0, pB1, mnB, alB, pA0, pA1, alA, t, 1, 0, 0);
        HALF_STEP(pA0, pA1, mnA, alA, pB0, pB1, alB, t + 1, 0, 1, 1);
    }
    SBAR(); { const float t0 = TB0(NT - 1); qkt<1>(pB0, pB1, K_lds, r32, hi, moff, qr, cb, t0, t0 + 32.f * c1); } SBAR();
    finishSM(pA0, pA1, alA, l_reg, pa0, pa1, pa2, pa3); SBAR();
    pv_tile<0>(o, vb0, pa0, pa1, pa2, pa3);
    MASKT(pB0, pB1, NT - 1); partialSM(pB0, pB1, m_reg, mnB, alB); __syncthreads(); RESC(alB);
    finishSM(pB0, pB1, alB, l_reg, pa0, pa1, pa2, pa3); SBAR(); pv_tile<1>(o, vb0, pa0, pa1, pa2, pa3);
    if (hi == 0) li_l[r32] = l_reg; asm volatile("s_waitcnt lgkmcnt(0)" ::: "memory");
#pragma unroll
    for (int r = 0; r < 16; ++r) { const float rl = __builtin_amdgcn_rcpf(li_l[crow(r, hi)]);
#pragma unroll
        for (int d0 = 0; d0 < 4; ++d0) o[d0][r] *= rl; }
    __syncthreads();
    float* X = (float*)lds + rg * 4096;
    if (mp == 1) {
#pragma unroll
        for (int d0 = 0; d0 < 4; ++d0)
#pragma unroll
            for (int r = 0; r < 16; ++r) X[(d0 * 16 + r) * 64 + lane] = o[d0][r];
    }
    __syncthreads();
    if (mp == 0) {
        float gs[4];
#pragma unroll
        for (int d0 = 0; d0 < 4; ++d0) gs[d0] = gsub[d0 * 32 + r32] * 0.8f;
#pragma unroll
        for (int r = 0; r < 16; ++r) {
            float y[4]; float ss = 0.f;
#pragma unroll
            for (int d0 = 0; d0 < 4; ++d0) { y[d0] = o[d0][r] - lam * X[(d0 * 16 + r) * 64 + lane]; ss += y[d0] * y[d0]; }
            ss += __shfl_xor(ss, 1); ss += __shfl_xor(ss, 2); ss += __shfl_xor(ss, 4); ss += __shfl_xor(ss, 8); ss += __shfl_xor(ss, 16);
            const float sc_ = __builtin_amdgcn_rsqf(ss * (1.0f / 128.0f) + 1e-6f);
            bf16_t* orow = AO + (size_t)(seq0 + qlo + crow(r, hi)) * 2048 + h * 128;
#pragma unroll
            for (int d0 = 0; d0 < 4; ++d0) { const float v = y[d0] * sc_ * gs[d0]; const float vn = __shfl_xor(v, 1);
                if ((r32 & 1) == 0) *(unsigned*)(orow + d0 * 32 + r32) = cvtpk(v, vn); }
        }
    }
    __syncthreads();
#undef SLOAD
#undef SWRITE
#undef TB0
#undef MASKT
#undef RESC
#undef HALF_STEP
}

typedef short s16x4b __attribute__((ext_vector_type(4)));
__device__ __forceinline__ void decode_unit(int b, int chunk, const float* __restrict__ cache_k, const float* __restrict__ cache_v, const int* __restrict__ page_table,
                                            const bf16_t* QB, float* DPO, float* DPM, float* DPL, char* lds) {
    typedef __attribute__((address_space(3))) s16x4b* lds_v4p;
    int tid_l = threadIdx.x; asm volatile("" : "+v"(tid_l));
    const int tid = tid_l, h = __builtin_amdgcn_readfirstlane(tid >> 6), lane = tid & 63, n = lane & 15, g = lane >> 4;
    const int unit = b * 32 + chunk;
    bf16x8 qf[4];
    { const int mq = n >> 3, tq = n & 7;
#pragma unroll
      for (int s4 = 0; s4 < 4; ++s4) { bf16x8 z = {0, 0, 0, 0, 0, 0, 0, 0};
          if ((s4 >> 1) == mq) z = *reinterpret_cast<const bf16x8*>(QB + (size_t)(mk::MP + b * 8 + tq) * 1024 + h * 128 + s4 * 32 + 8 * g);
          qf[s4] = z; } }
    const float slope_l2 = __builtin_amdgcn_exp2f(-(float)(h + 1)) * mk::LOG2E;
    float m_run = -1e30f, l_run = 0.f; f32x4 o[8];
#pragma unroll
    for (int i = 0; i < 8; ++i) o[i] = (f32x4){0.f, 0.f, 0.f, 0.f};
    f32x4 kreg[8], vreg[8];
    const int wtok = tid >> 8, whh = (tid & 255) >> 5, wd = (tid & 31) * 4;
#define DLOADS(s) do { const int pg_ = page_table[b * mk::NPAGES + chunk * 4 + ((s) >> 3)]; const size_t base_ = (size_t)pg_ * 131072 + (size_t)((s) & 7) * 16384 + (size_t)tid * 4; \
        _Pragma("unroll") for (int i = 0; i < 8; ++i) { kreg[i] = *(const f32x4*)(cache_k + base_ + i * 2048); vreg[i] = *(const f32x4*)(cache_v + base_ + i * 2048); } } while (0)
#define DWRITES(buf) do { _Pragma("unroll") for (int i = 0; i < 8; ++i) { const int tok_ = 2 * i + wtok; \
        uint2 kw_, vw_; kw_.x = cvtpk(kreg[i][0], kreg[i][1]); kw_.y = cvtpk(kreg[i][2], kreg[i][3]); vw_.x = cvtpk(vreg[i][0], vreg[i][1]); vw_.y = cvtpk(vreg[i][2], vreg[i][3]); \
        *(uint2*)(lds + (buf) * 65536 + whh * 4096 + tok_ * 256 + ((wd * 2) ^ ((tok_ & 7) << 4))) = kw_; \
        *(uint2*)(lds + (buf) * 65536 + 32768 + whh * 4096 + tok_ * 256 + ((wd * 2) ^ ((tok_ & 7) << 5))) = vw_; } } while (0)
    const int tq_ = n >> 2, tp_ = n & 3;
    DLOADS(0); VMW(); DWRITES(0);
    __syncthreads();
    for (int s = 0; s < 32; ++s) {
        if (s + 1 < 32) DLOADS(s + 1);
        {
            const char* Kb = lds + (s & 1) * 65536 + h * 4096; const char* Vb = Kb + 32768;
            f32x4 S = (f32x4){0.f, 0.f, 0.f, 0.f};
#pragma unroll
            for (int s4 = 0; s4 < 4; ++s4) {
                const bf16x8 a = *reinterpret_cast<const bf16x8*>(Kb + n * 256 + (((s4 * 32 + 8 * g) * 2) ^ ((n & 7) << 4)));
                S = __builtin_amdgcn_mfma_f32_16x16x32_bf16(a, qf[s4], S, 0, 0, 0);
            }
            const int kpos0 = (chunk * 4 + (s >> 3)) * mk::PAGE + (s & 7) * 16 - mk::PAST + 4 * g;
            float s2[4];
#pragma unroll
            for (int r = 0; r < 4; ++r) s2[r] = S[r] * (SCALE * mk::LOG2E) + slope_l2 * (float)(kpos0 + r);
            float mx = fmaxf(fmaxf(s2[0], s2[1]), fmaxf(s2[2], s2[3]));
            mx = fmaxf(mx, __shfl_xor(mx, 16)); mx = fmaxf(mx, __shfl_xor(mx, 32));
            const float mnew = fmaxf(m_run, mx), alpha = __builtin_amdgcn_exp2f(m_run - mnew); m_run = mnew;
            float p[4];
#pragma unroll
            for (int r = 0; r < 4; ++r) p[r] = __builtin_amdgcn_exp2f(s2[r] - mnew);
            l_run = l_run * alpha + ((p[0] + p[1]) + (p[2] + p[3]));
            uint2 pw; pw.x = cvtpk(p[0], p[1]); pw.y = cvtpk(p[2], p[3]);
            const s16x4b pa = __builtin_bit_cast(s16x4b, pw);
            if (__any(alpha < 1.f)) {
                const float a0 = __shfl(alpha, 4 * g + 0), a1 = __shfl(alpha, 4 * g + 1), a2 = __shfl(alpha, 4 * g + 2), a3 = __shfl(alpha, 4 * g + 3);
#pragma unroll
                for (int i = 0; i < 8; ++i) { o[i][0] *= a0; o[i][1] *= a1; o[i][2] *= a2; o[i][3] *= a3; }
            }
            const int vtok = 4 * g + tq_;
#pragma unroll
            for (int blk = 0; blk < 8; ++blk) {
                const char* va = Vb + vtok * 256 + (((16 * blk + 4 * tp_) * 2) ^ ((vtok & 7) << 5));
                const s16x4b vf = __builtin_bit_cast(s16x4b, __builtin_amdgcn_ds_read_tr16_b64_v4i16((lds_v4p)va));
                o[blk] = __builtin_amdgcn_mfma_f32_16x16x16bf16_1k(pa, vf, o[blk], 0, 0, 0);
            }
        }
        if (s + 1 < 32) { VMW(); DWRITES((s + 1) & 1); }
        __syncthreads();
    }
    l_run += __shfl_xor(l_run, 16); l_run += __shfl_xor(l_run, 32);
    if (g == 0) { DPM[(unit * 8 + h) * 16 + n] = m_run; DPL[(unit * 8 + h) * 16 + n] = l_run; }
#pragma unroll
    for (int blk = 0; blk < 8; ++blk)
#pragma unroll
        for (int r = 0; r < 4; ++r) DPO[((size_t)(unit * 8 + h) * 16 + (4 * g + r)) * 128 + 16 * blk + n] = o[blk][r];
#undef DLOADS
#undef DWRITES
}
__device__ __forceinline__ float wsum(float v) {
#pragma unroll
    for (int o = 1; o < 64; o <<= 1) v += __shfl_xor(v, o);
    return v;
}
__device__ __forceinline__ void decode_combine(int item, const bf16_t* QB, const bf16_t* KBp, const bf16_t* VBp, const float* DPO, const float* DPM, const float* DPL,
                                               bf16_t* AO, float lam, const float* gsub, int lane) {
    const int b = item >> 6, h = (item >> 3) & 7, t = item & 7, row = mk::MP + b * 8 + t;
    const float slope_l2 = __builtin_amdgcn_exp2f(-(float)(h + 1)) * mk::LOG2E;
    float on[2][2];
#pragma unroll
    for (int m = 0; m < 2; ++m) {
        const float qv = bf2f(QB[(size_t)row * 1024 + h * 128 + m * 64 + lane]);
        float sn[8];
#pragma unroll
        for (int t2 = 0; t2 < 8; ++t2) { const float kv = bf2f(KBp[(size_t)(mk::MP + b * 8 + t2) * 1024 + h * 128 + m * 64 + lane]);
            sn[t2] = wsum(qv * kv) * (SCALE * mk::LOG2E) + slope_l2 * (float)t2; }
        const int col = m * 8 + t;
        float M = -1e30f;
        for (int u = 0; u < 32; ++u) M = fmaxf(M, DPM[((b * 32 + u) * 8 + h) * 16 + col]);
#pragma unroll
        for (int t2 = 0; t2 < 8; ++t2) if (t2 <= t) M = fmaxf(M, sn[t2]);
        float L = 0.f, O0 = 0.f, O1 = 0.f;
        for (int u = 0; u < 32; ++u) { const int pi = ((b * 32 + u) * 8 + h) * 16 + col; const float w = __builtin_amdgcn_exp2f(DPM[pi] - M);
            L += DPL[pi] * w; const float2 ov = *(const float2*)(DPO + (size_t)pi * 128 + 2 * lane); O0 += ov.x * w; O1 += ov.y * w; }
#pragma unroll
        for (int t2 = 0; t2 < 8; ++t2) if (t2 <= t) { const float p = __builtin_amdgcn_exp2f(sn[t2] - M); L += p;
            const unsigned vv = *(const unsigned*)(VBp + (size_t)(mk::MP + b * 8 + t2) * 1024 + h * 128 + 2 * lane);
            O0 += p * __uint_as_float(vv << 16); O1 += p * __uint_as_float(vv & 0xffff0000u); }
        const float rl = 1.0f / L; on[m][0] = O0 * rl; on[m][1] = O1 * rl;
    }
    const float y0 = on[0][0] - lam * on[1][0], y1 = on[0][1] - lam * on[1][1];
    const float ss = wsum(y0 * y0 + y1 * y1);
    const float sc_ = __builtin_amdgcn_rsqf(ss * (1.0f / 128.0f) + 1e-6f) * 0.8f;
    const float2 gg = *(const float2*)(gsub + 2 * lane);
    *(unsigned*)(AO + (size_t)row * 2048 + h * 128 + 2 * lane) = cvtpk(y0 * sc_ * gg.x, y1 * sc_ * gg.y);
}

__device__ __forceinline__ void conv_unit(int unit, const float* U, const float* state_conv, const float* w_dw, const float* b_dw, const float* g_cn, const float* b_cn, bf16_t* AO, char* lds) {
    int tid_l = threadIdx.x; asm volatile("" : "+v"(tid_l));
    const int tid = tid_l, wid = __builtin_amdgcn_readfirstlane(tid >> 6), lane = tid & 63;
    float* T = (float*)lds;
    const bool samp = unit >= 2048;
    int grp, row0, nrows, t0 = 0, bs = 0;
    if (!samp) { grp = unit & 7; const int tile = unit >> 3; row0 = tile * 32; t0 = row0 & 2047; nrows = 62; }
    else { const int su = unit - 2048; grp = su & 7; bs = su >> 3; row0 = mk::MP + bs * 8; nrows = 38; }
    for (int idx = tid; idx < nrows * 32; idx += 512) {
        const int i = idx >> 5, c4 = (idx & 31) * 4; f32x4 v = (f32x4){0.f, 0.f, 0.f, 0.f};
        const int tau = i - 30;
        if (!samp) { if (t0 + tau >= 0) v = *(const f32x4*)(U + (size_t)(row0 + tau) * 1024 + grp * 128 + c4); }
        else { if (tau < 0) v = *(const f32x4*)(state_conv + (size_t)(bs * 30 + 30 + tau) * 1024 + grp * 128 + c4);
               else v = *(const f32x4*)(U + (size_t)(row0 + tau) * 1024 + grp * 128 + c4); }
        *(f32x4*)(T + i * 128 + c4) = v;
    }
    const int ch = grp * 128 + 2 * lane;
    float2 w[31];
#pragma unroll
    for (int j = 0; j < 31; ++j) w[j] = *(const float2*)(w_dw + (size_t)j * 1024 + ch);
    const float2 bd = *(const float2*)(b_dw + ch), gc = *(const float2*)(g_cn + ch), bc = *(const float2*)(b_cn + ch);
    __syncthreads();
    const int ntok = samp ? 1 : 4, tokb = samp ? wid : wid * 4;
    for (int k = 0; k < ntok; ++k) {
        const int tt = tokb + k;
        float a0 = bd.x, a1 = bd.y;
#pragma unroll
        for (int j = 0; j < 31; ++j) { const float2 x = *(const float2*)(T + (tt + j) * 128 + 2 * lane); a0 = fmaf(w[j].x, x.x, a0); a1 = fmaf(w[j].y, x.y, a1); }
        const float mean = wsum(a0 + a1) * (1.0f / 128.0f);
        const float d0 = a0 - mean, d1 = a1 - mean;
        const float var = wsum(d0 * d0 + d1 * d1) * (1.0f / 128.0f);
        const float rs = __builtin_amdgcn_rsqf(var + 1e-5f);
        const float y0 = d0 * rs * gc.x + bc.x, y1 = d1 * rs * gc.y + bc.y;
        const float o0 = y0 * __builtin_amdgcn_rcpf(1.0f + __builtin_amdgcn_exp2f(-y0 * mk::LOG2E)), o1 = y1 * __builtin_amdgcn_rcpf(1.0f + __builtin_amdgcn_exp2f(-y1 * mk::LOG2E));
        *(unsigned*)(AO + (size_t)(row0 + tt) * 2048 + 1024 + ch) = cvtpk(o0, o1);
    }
    __syncthreads();
}
#undef VMW
#undef SBAR
#undef KSWZ
}
namespace mk {
constexpr int NWAVES = 8;
constexpr size_t MiB = 1u << 20;
constexpr size_t WS_CTL = 0, CTL_ZERO_BYTES = 1 * MiB;
constexpr size_t WS_W1T = 1 * MiB;
constexpr size_t WS_W2T = WS_W1T + 44 * MiB;
constexpr size_t WS_WINT = WS_W2T + 22 * MiB;
constexpr size_t WS_WOT = WS_WINT + 20 * MiB;
constexpr size_t WS_W3T = WS_WOT + 8 * MiB;
constexpr size_t WS_W4T = WS_W3T + 44 * MiB;
constexpr size_t WS_WPGT = WS_W4T + 22 * MiB;
constexpr size_t WS_WPPT = WS_WPGT + 8 * MiB;
constexpr size_t WS_XB = WS_WPPT + 1 * MiB;
constexpr size_t WS_PB = WS_XB + 33 * MiB;
constexpr size_t WS_ACT = WS_PB + 5 * MiB;
constexpr size_t WS_H1 = WS_ACT + 91 * MiB;
constexpr size_t WS_H1B = WS_H1 + 66 * MiB;
constexpr size_t WS_QB = WS_H1B + 33 * MiB;
constexpr size_t WS_KB = WS_QB + 17 * MiB;
constexpr size_t WS_VB = WS_KB + 17 * MiB;
constexpr size_t WS_U = WS_VB + 17 * MiB;
constexpr size_t WS_AO = WS_U + 33 * MiB;
constexpr size_t WS_H2 = WS_AO + 33 * MiB;
constexpr size_t WS_H2B = WS_H2 + 66 * MiB;
constexpr size_t WS_H3 = WS_H2B + 33 * MiB;
constexpr size_t WS_H3B = WS_H3 + 66 * MiB;
constexpr size_t WS_PJ = WS_H3B + 33 * MiB;
constexpr size_t WS_H4 = WS_PJ + 66 * MiB;
constexpr size_t WS_ST1 = WS_H4 + 66 * MiB;
constexpr size_t WS_ST2 = WS_ST1 + 1 * MiB;
constexpr size_t WS_ST3 = WS_ST2 + 1 * MiB;
constexpr size_t WS_ST4 = WS_ST3 + 1 * MiB;
constexpr size_t WS_DPO = WS_ST4 + 1 * MiB;
constexpr size_t WS_DPM = WS_DPO + 16 * MiB;
constexpr size_t WS_DPL = WS_DPM + 1 * MiB;
constexpr size_t WS_END = WS_DPL + 1 * MiB;
static_assert((size_t)MPAD * 2048 * 2 <= 33 * MiB && (size_t)MPAD * 5632 * 2 <= 91 * MiB && (size_t)MPAD * 2048 * 4 <= 66 * MiB && (size_t)MPAD * 1024 * 2 <= 17 * MiB, "ws map");
constexpr int CW_BAR = 4096;
constexpr int RING_BYTES = 131072, PST_OFF = RING_BYTES, MISC_OFF = PST_OFF + 4096, LDS_BYTES = 147456;
}


namespace mk {
__device__ __forceinline__ float wave_sum(float v) {
#pragma unroll
    for (int o = 1; o < 64; o <<= 1) v += __shfl_xor(v, o);
    return v;
}
__device__ __forceinline__ void tr_item(const float* W, const float* gain, int K, int N, bf16* WT, int k0, int n0, int dst_row0, LAS float* scr, int lane) {
#pragma unroll 8
    for (int i = 0; i < 32; ++i) { const int kk = 2 * i + (lane >> 5); scr[kk * 33 + (lane & 31)] = W[(size_t)(k0 + kk) * N + n0 + (lane & 31)]; }
    LDS_WAIT(); asm volatile("" ::: "memory");
    const int c = lane & 7;
    float gv[8];
#pragma unroll
    for (int j = 0; j < 8; ++j) gv[j] = gain ? gain[k0 + 8 * c + j] : 1.0f;
#pragma unroll
    for (int j = 0; j < 4; ++j) { const int n = (lane >> 3) + 8 * j; const LAS float* s = scr + (8 * c) * 33 + n;
        v4u o; o.x = pk2(s[0 * 33] * gv[0], s[1 * 33] * gv[1]); o.y = pk2(s[2 * 33] * gv[2], s[3 * 33] * gv[3]); o.z = pk2(s[4 * 33] * gv[4], s[5 * 33] * gv[5]); o.w = pk2(s[6 * 33] * gv[6], s[7 * 33] * gv[7]);
        *(GAS v4u*)(WT + (size_t)(dst_row0 + n) * K + k0 + 8 * c) = o; }
    LDS_WAIT(); asm volatile("" ::: "memory");
}
__device__ __forceinline__ void tr_matrix_item(const float* W, const float* gain, int K, int N, bf16* WT, int mode, int item, LAS float* scr, int lane) {
    const int nblk = N / 32, kb = item / nblk, nb = item % nblk, k0 = 64 * kb, n0 = 32 * nb;
    int dr = n0;
    if (mode == 1 || mode == 2) dr = 256 * (n0 >> 7) + 128 * (mode - 1) + (n0 & 127);
    else if (mode == 3 && n0 >= 3072) { const int j = n0 - 3072, half = j >> 10, jj = j & 1023; dr = 3072 + 256 * (jj >> 7) + 128 * half + (jj & 127); }
    tr_item(W, gain, K, N, WT, k0, n0, dr, scr, lane);
}

struct Args { const void* in[32]; float* out; unsigned char* ws; int ph_lo, ph_hi; };
constexpr int N_PHASES = 11;

__global__ void __launch_bounds__(NWAVES * 64, 2) hymba_fwd(Args args) {
    extern __shared__ __attribute__((aligned(16))) unsigned char lds[];
    LAS unsigned char* ldsl = (LAS unsigned char*)lds;
    volatile LAS unsigned* MISC = (volatile LAS unsigned*)(ldsl + MISC_OFF);
#define LOCAL_IDS() int tid_l = threadIdx.x; asm volatile("" : "+v"(tid_l)); const int lane = tid_l & 63, wave = __builtin_amdgcn_readfirstlane(tid_l >> 6), gw = vcu * NWAVES + wave, NGW = G * NWAVES; (void)lane; (void)gw; (void)NGW
    const int G = gridDim.x; const int bx = blockIdx.x; const int vcu = (G % 8 == 0) ? (bx % 8) * (G / 8) + bx / 8 : bx;
#define WSP(T, off) ((T*)(args.ws + (off)))
#define INF(i) ((const float*)args.in[i])
    gu32* ctl = (gu32*)(args.ws + WS_CTL);
    float* out = args.out;
    for (int u = threadIdx.x; u < (LDS_BYTES - PST_OFF) / 4; u += NWAVES * 64) ((LAS unsigned*)(ldsl + PST_OFF))[u] = 0u;
    __syncthreads();
    XcdBarrier bar = xcd_barrier_post((unsigned*)(ctl + CW_BAR), MISC + 8);
    const int lo = args.ph_lo, hi = args.ph_hi;
#define IN(k) (lo <= (k) && (k) < hi)
#define GRID_BAR(k) do { if (IN(k) && IN((k) + 1)) xcd_barrier(bar); } while (0)

    if (IN(0)) {
        LOCAL_IDS();
        LAS float* scr = (LAS float*)(ldsl + wave * 16384);
        constexpr int I_GU = 32 * 176, I_DN = 88 * 64, I_IN = 32 * 160, I_SQ = 32 * 64, I_PP = 4 * 64;
        constexpr int NITEMS = 4 * I_GU + 2 * I_DN + I_IN + 2 * I_SQ + I_PP;
        for (int it = gw; it < NITEMS; it += NGW) {
            int r = it;
            if (r < I_GU) { tr_matrix_item(INF(9), INF(8), D, FF, WSP(bf16, WS_W1T), 1, r, scr, lane); continue; } r -= I_GU;
            if (r < I_GU) { tr_matrix_item(INF(10), INF(8), D, FF, WSP(bf16, WS_W1T), 2, r, scr, lane); continue; } r -= I_GU;
            if (r < I_DN) { tr_matrix_item(INF(11), nullptr, FF, D, WSP(bf16, WS_W2T), 0, r, scr, lane); continue; } r -= I_DN;
            if (r < I_IN) { tr_matrix_item(INF(13), INF(12), D, NIN, WSP(bf16, WS_WINT), 3, r, scr, lane); continue; } r -= I_IN;
            if (r < I_SQ) { tr_matrix_item(INF(23), nullptr, D, D, WSP(bf16, WS_WOT), 0, r, scr, lane); continue; } r -= I_SQ;
            if (r < I_GU) { tr_matrix_item(INF(25), INF(24), D, FF, WSP(bf16, WS_W3T), 1, r, scr, lane); continue; } r -= I_GU;
            if (r < I_GU) { tr_matrix_item(INF(26), INF(24), D, FF, WSP(bf16, WS_W3T), 2, r, scr, lane); continue; } r -= I_GU;
            if (r < I_DN) { tr_matrix_item(INF(27), nullptr, FF, D, WSP(bf16, WS_W4T), 0, r, scr, lane); continue; } r -= I_DN;
            if (r < I_SQ) { tr_matrix_item(INF(29), INF(28), D, D, WSP(bf16, WS_WPGT), 0, r, scr, lane); continue; } r -= I_SQ;
            tr_matrix_item(INF(30), nullptr, DPLE, D, WSP(bf16, WS_WPPT), 0, r, scr, lane);
        }
        {
        const float* x_prompt = INF(0); const float* x_sample = INF(1); const float* p_prompt = INF(6); const float* p_sample = INF(7);
        bf16* XB = WSP(bf16, WS_XB); bf16* PB = WSP(bf16, WS_PB); float* ST1 = WSP(float, WS_ST1);
        for (int m = gw; m < MREAL; m += NGW) {
            const float* xr = m < MP ? x_prompt + (size_t)m * D : x_sample + (size_t)(m - MP) * D;
            const GAS f32x4* xv = (const GAS f32x4*)xr + lane;
            f32x4 v[8]; float s = 0.f;
#pragma unroll
            for (int j = 0; j < 8; ++j) { v[j] = xv[64 * j]; s += (v[j].x * v[j].x + v[j].y * v[j].y) + (v[j].z * v[j].z + v[j].w * v[j].w); }
            s = wave_sum(s);
            GAS unsigned long long* o8 = (GAS unsigned long long*)(XB + (size_t)m * D) + lane;
#pragma unroll
            for (int j = 0; j < 8; ++j) o8[64 * j] = (unsigned long long)pk2(v[j].x, v[j].y) | ((unsigned long long)pk2(v[j].z, v[j].w) << 32);
            if (lane < 2) *(GAS f32x4*)(ST1 + (size_t)m * 8 + 4 * lane) = (f32x4){lane == 0 ? s : 0.f, 0.f, 0.f, 0.f};
            const float* pr = m < MP ? p_prompt + (size_t)m * DPLE : p_sample + (size_t)(m - MP) * DPLE;
            const f32x4 pv = ((const GAS f32x4*)pr)[lane];
            ((GAS unsigned long long*)(PB + (size_t)m * DPLE))[lane] = (unsigned long long)pk2(pv.x, pv.y) | ((unsigned long long)pk2(pv.z, pv.w) << 32);
        }
        const int gt = gw * 64 + lane, NGT = NGW * 64;
        const v4u z4 = (v4u){0u, 0u, 0u, 0u};
        bf16* AO = WSP(bf16, WS_AO); const float* state_conv = INF(4);
        for (int i = gt; i < (MPAD - MREAL) * D * 2 / 16; i += NGT) { ((GAS v4u*)(XB + (size_t)MREAL * D))[i] = z4; ((GAS v4u*)(AO + (size_t)MREAL * D))[i] = z4; }
        for (int i = gt; i < (MPAD - MREAL) * DPLE * 2 / 16; i += NGT) ((GAS v4u*)(PB + (size_t)MREAL * DPLE))[i] = z4;
        for (int i = gt; i < (MPAD - MREAL) * 8 * 4 / 16; i += NGT) ((GAS v4u*)(ST1 + (size_t)MREAL * 8))[i] = z4;
        for (int i = gt; i < DB * 22 * 256; i += NGT) { const int bs = i / (22 * 256), rem = i % (22 * 256), rr = rem >> 8, c4 = (rem & 255) * 4;
            *(GAS f32x4*)(out + OC_S + (size_t)(bs * 30 + rr) * CW + c4) = *(const GAS f32x4*)(state_conv + (size_t)(bs * 30 + rr + 8) * CW + c4); }
        }
    }
    GRID_BAR(0);

    if (IN(1)) {
        { pg8::Gemm g{WSP(bf16, WS_PB), WSP(bf16, WS_WPPT), MPAD, D, DPLE}; pg8::StaticOrder S; S.init(MPAD, D, G, bx); pg8::EpiF32 E{WSP(float, WS_PJ)};
          pg8::gemm_phase<pg8::EpiF32, pg8::StaticOrder, true, true>(ldsl, g, S, E); }
        { pg8::Gemm g{WSP(bf16, WS_XB), WSP(bf16, WS_W1T), MPAD, 2 * FF, D}; pg8::StaticOrder S; S.init(MPAD, 2 * FF, G, bx); pg8::EpiSwiGLU E{WSP(bf16, WS_ACT), WSP(float, WS_ST1), FF};
          pg8::gemm_phase<pg8::EpiSwiGLU, pg8::StaticOrder, true, true>(ldsl, g, S, E); }
    }
    GRID_BAR(1);
    if (IN(2)) {
        pg8::Gemm g{WSP(bf16, WS_ACT), WSP(bf16, WS_W2T), MPAD, D, FF}; pg8::StaticOrder S; S.init(MPAD, D, G, bx);
        pg8::EpiResid<1> E{INF(0), INF(1), MP, MREAL, WSP(float, WS_H1), WSP(bf16, WS_H1B), WSP(float, WS_ST2)};
        pg8::gemm_phase<pg8::EpiResid<1>, pg8::StaticOrder, true, true>(ldsl, g, S, E);
    }
    GRID_BAR(2);
    if (IN(3)) {
        pg8::Gemm g{WSP(bf16, WS_H1B), WSP(bf16, WS_WINT), MPAD, NIN, D}; pg8::StaticOrder S; S.init(MPAD, NIN, G, bx);
        pg8::EpiWin E{WSP(float, WS_ST2), WSP(bf16, WS_QB), (WS_KB - WS_QB) / 2, WSP(float, WS_U), out};
        pg8::gemm_phase<pg8::EpiWin, pg8::StaticOrder, true, true>(ldsl, g, S, E);
    }
    GRID_BAR(3);
    if (IN(4)) {
        LOCAL_IDS();
        float lam; { const float a = INF(14)[lane] * INF(15)[lane], b = INF(16)[lane] * INF(17)[lane]; lam = __expf(wave_sum(a)) - __expf(wave_sum(b)) + 0.2f; }
        const int bh = vcu >> 3, s8 = vcu & 7, ab = bh >> 3, ah = bh & 7;
        const float c1 = 8.0f * __builtin_amdgcn_exp2f(-(float)(ah + 1));
        for (int pass = 0; pass < 2; ++pass) {
            if (((pass ^ vcu) & 1) == 0) {
                for (int k = 0; k < 2; ++k)
                    att::attn_block(WSP(bf16, WS_QB), WSP(bf16, WS_KB), WSP(bf16, WS_VB), WSP(bf16, WS_AO), ab * SEQ, (k ? 15 - s8 : s8) * 128, ah, c1, lam, INF(18), (char*)lds);
            } else {
                att::decode_unit(vcu >> 5, vcu & 31, INF(2), INF(3), (const int*)args.in[5], WSP(bf16, WS_QB), WSP(float, WS_DPO), WSP(float, WS_DPM), WSP(float, WS_DPL), (char*)lds);
            }
        }
        for (int cu = vcu; cu < 2048 + 64; cu += G) att::conv_unit(cu, WSP(float, WS_U), INF(4), INF(19), INF(20), INF(21), INF(22), WSP(bf16, WS_AO), (char*)lds);
    }
    GRID_BAR(4);
    if (IN(5)) {
        LOCAL_IDS();
        float lam; { const float a = INF(14)[lane] * INF(15)[lane], b = INF(16)[lane] * INF(17)[lane]; lam = __expf(wave_sum(a)) - __expf(wave_sum(b)) + 0.2f; }
        for (int it = gw; it < DB * NH * DT; it += NGW)
            att::decode_combine(it, WSP(bf16, WS_QB), WSP(bf16, WS_KB), WSP(bf16, WS_VB), WSP(float, WS_DPO), WSP(float, WS_DPM), WSP(float, WS_DPL), WSP(bf16, WS_AO), lam, INF(18), lane);
    }
    GRID_BAR(5);
    if (IN(6)) {
        pg8::Gemm g{WSP(bf16, WS_AO), WSP(bf16, WS_WOT), MPAD, D, D}; pg8::StaticOrder S; S.init(MPAD, D, G, bx);
        pg8::EpiResid<2> E{WSP(float, WS_H1), WSP(float, WS_H1), MPAD, MPAD, WSP(float, WS_H2), WSP(bf16, WS_H2B), WSP(float, WS_ST3)};
        pg8::gemm_phase<pg8::EpiResid<2>, pg8::StaticOrder, true, true>(ldsl, g, S, E);
    }
    GRID_BAR(6);
    if (IN(7)) {
        pg8::Gemm g{WSP(bf16, WS_H2B), WSP(bf16, WS_W3T), MPAD, 2 * FF, D}; pg8::StaticOrder S; S.init(MPAD, 2 * FF, G, bx); pg8::EpiSwiGLU E{WSP(bf16, WS_ACT), WSP(float, WS_ST3), FF};
        pg8::gemm_phase<pg8::EpiSwiGLU, pg8::StaticOrder, true, true>(ldsl, g, S, E);
    }
    GRID_BAR(7);
    if (IN(8)) {
        pg8::Gemm g{WSP(bf16, WS_ACT), WSP(bf16, WS_W4T), MPAD, D, FF}; pg8::StaticOrder S; S.init(MPAD, D, G, bx);
        pg8::EpiResid<1> E{WSP(float, WS_H2), WSP(float, WS_H2), MPAD, MPAD, WSP(float, WS_H3), WSP(bf16, WS_H3B), WSP(float, WS_ST4)};
        pg8::gemm_phase<pg8::EpiResid<1>, pg8::StaticOrder, true, true>(ldsl, g, S, E);
    }
    GRID_BAR(8);
    if (IN(9)) {
        pg8::Gemm g{WSP(bf16, WS_H3B), WSP(bf16, WS_WPGT), MPAD, D, D}; pg8::StaticOrder S; S.init(MPAD, D, G, bx); pg8::EpiPle E{WSP(float, WS_ST4), WSP(float, WS_H3), WSP(float, WS_PJ), WSP(float, WS_H4)};
        pg8::gemm_phase<pg8::EpiPle, pg8::StaticOrder, true, true>(ldsl, g, S, E);
    }
    GRID_BAR(9);
    if (IN(10)) {
        LOCAL_IDS();
        const float* H4 = WSP(float, WS_H4); const float* g_final = INF(31);
        for (int m = gw; m < MREAL; m += NGW) {
            const GAS f32x4* hv = (const GAS f32x4*)(H4 + (size_t)m * D) + lane;
            f32x4 v[8]; float s = 0.f;
#pragma unroll
            for (int j = 0; j < 8; ++j) { v[j] = hv[64 * j]; s += (v[j].x * v[j].x + v[j].y * v[j].y) + (v[j].z * v[j].z + v[j].w * v[j].w); }
            const float r = __builtin_amdgcn_rsqf(wave_sum(s) * (1.0f / D) + 1e-6f);
            float* orow = m < MP ? out + OY_P + (size_t)m * D : out + OY_S + (size_t)(m - MP) * D;
#pragma unroll
            for (int j = 0; j < 8; ++j) { const f32x4 gf = ((const GAS f32x4*)g_final)[lane + 64 * j]; ((GAS f32x4*)orow)[lane + 64 * j] = v[j] * r * gf; }
        }
    }
#undef IN
#undef GRID_BAR
#undef WSP
#undef INF
}
}

extern "C" void kernel_launch(void* const* d_in, const int* in_sizes, int n_in, void* d_out, int out_size, void* d_ws, size_t ws_size, hipStream_t stream) {
    using namespace mk;
    static int grid = 0;
    if (grid == 0) {
        if (n_in != 32 || out_size != (int)O_END || ws_size < WS_END) { fprintf(stderr, "kernel_launch: unexpected problem shape (n_in %d, out %d, ws %zu); nothing launched\n", n_in, out_size, ws_size); grid = -1; return; }
        int dev = 0, cus = 0, per_cu = 0;
        if (hipGetDevice(&dev) != hipSuccess || hipDeviceGetAttribute(&cus, hipDeviceAttributeMultiprocessorCount, dev) != hipSuccess) { grid = -1; return; }
        if (hipFuncSetAttribute((const void*)hymba_fwd, hipFuncAttributeMaxDynamicSharedMemorySize, LDS_BYTES) != hipSuccess) { fprintf(stderr, "kernel_launch: hipFuncSetAttribute failed\n"); grid = -1; return; }
        if (hipOccupancyMaxActiveBlocksPerMultiprocessor(&per_cu, (const void*)hymba_fwd, NWAVES * 64, LDS_BYTES) != hipSuccess || per_cu < 1)
            fprintf(stderr, "kernel_launch: note: occupancy query reports %d workgroups per CU\n", per_cu);
        (void)hipGetLastError();
        grid = cus;
    }
    if (grid < 0) return;
    if (hipMemsetAsync((char*)d_ws + WS_CTL, 0, CTL_ZERO_BYTES, stream) != hipSuccess) return;
    Args a{};
    for (int i = 0; i < 32; ++i) a.in[i] = d_in[i];
    a.out = (float*)d_out; a.ws = (unsigned char*)d_ws;
#ifndef MK_N_LAUNCHES
#define MK_N_LAUNCHES 1
#endif
    if (MK_N_LAUNCHES == 1) { a.ph_lo = 0; a.ph_hi = N_PHASES; hipLaunchKernelGGL(hymba_fwd, dim3(grid), dim3(NWAVES * 64), LDS_BYTES, stream, a); }
    else { for (int p = 0; p < N_PHASES; ++p) { a.ph_lo = p; a.ph_hi = p + 1; hipLaunchKernelGGL(hymba_fwd, dim3(grid), dim3(NWAVES * 64), LDS_BYTES, stream, a); } }
}
```

```cpp
#include <hip/hip_runtime.h>
#include <cstdio>
#include <cstdint>

namespace mk {
constexpr int D = 2048, FF = 5632, NIN = 5120, DPLE = 256, CW = 1024;
constexpr int MP = 8192, MS = 64, MREAL = MP + MS, MPAD = 8448;
constexpr int SEQ = 2048, NB = 4, NH = 8, DB = 8, DT = 8;
constexpr int NPAGES = 128, PAGE = 128, PAST = NPAGES * PAGE;
constexpr float LOG2E = 1.4426950408889634f;
constexpr size_t OY_P = 0, OY_S = OY_P + (size_t)MP * D, OK_P = OY_S + (size_t)MS * D, OV_P = OK_P + (size_t)MP * 1024, OC_P = OV_P + (size_t)MP * 1024,
                 OK_S = OC_P + (size_t)NB * 30 * CW, OV_S = OK_S + (size_t)MS * 1024, OC_S = OV_S + (size_t)MS * 1024, O_END = OC_S + (size_t)DB * 30 * CW;
static_assert(O_END == 34185216, "output size");
}
namespace pg8 {
#define PG8_LAS __attribute__((address_space(3)))
typedef unsigned short bf16_t;
typedef short bf16x8 __attribute__((ext_vector_type(8)));
typedef float f32x4 __attribute__((ext_vector_type(4)));
typedef unsigned u32x4 __attribute__((ext_vector_type(4)));
constexpr int BM = 256, BK = 64, HALF = 128, HTB = HALF * BK * 2  , STAGE_BYTES = 8 * HTB, NXCD = 8, WGM = 8;

__host__ __device__ __forceinline__ int lds_byte(int r, int c) { const int st = (r >> 4) * 2 + (c >> 5), rr = r & 15, cc = c & 31, ob = rr * 64 + cc * 2; return st * 1024 + (ob ^ (((ob >> 9) & 1) << 5)); }
__host__ __device__ __forceinline__ void stage_rc(int b, int& R, int& C) { const int st = b / 1024, sb = b % 1024, swz = sb ^ (((sb >> 9) & 1) << 5); R = (st >> 1) * 16 + swz / 64; C = (st & 1) * 32 + (swz % 64) / 2; }
__host__ __device__ __forceinline__ int perm32(int rho) { const int n = rho >> 4, i = rho & 15; return 8 * (i >> 2) + 4 * n + (i & 3); }

struct Unit { int pm, pn; };
struct Gemm { const bf16_t* A; const bf16_t* Bt; int M, N, K; };

struct StaticOrder {
    int nM, nN, nwg, G, c;
    __host__ __device__ void init(int M, int N, int G_, int c_) { nM = M / BM; nN = N / BM; nwg = nM * nN; G = G_; c = c_; }
    __host__ __device__ bool next(int i, Unit& u) const {
        const long L = (long)i * G + c; if (L >= nwg) return false;
        int wgid = (int)L; { const int q = nwg / NXCD, r = nwg % NXCD, xcd = wgid % NXCD, off = wgid / NXCD; wgid = (xcd < r ? xcd * (q + 1) : r * (q + 1) + (xcd - r) * q) + off; }
        const int nig = WGM * nN, gid = wgid / nig, fm = gid * WGM, gsz = (nM - fm) < WGM ? (nM - fm) : WGM;
        u.pm = fm + ((wgid % nig) % gsz); u.pn = (wgid % nig) / gsz; return true;
    }
    __device__ __forceinline__ void a_ready(const Unit&) const {}
    __device__ __forceinline__ void done(const Unit&) const {}
};

__device__ __forceinline__ unsigned cvt_pk_bf16(float lo, float hi) { unsigned r; asm volatile("v_cvt_pk_bf16_f32 %0, %1, %2" : "=v"(r) : "v"(lo), "v"(hi)); return r; }
typedef float f32x2 __attribute__((ext_vector_type(2)));
__device__ __forceinline__ float row_rstd(const float* st, int row) {
    const f32x4 a = *(const f32x4*)(st + (size_t)row * 8), b = *(const f32x4*)(st + (size_t)row * 8 + 4);
    const float s = ((a[0] + a[1]) + (a[2] + a[3])) + ((b[0] + b[1]) + (b[2] + b[3]));
    return __builtin_amdgcn_rsqf(s * (1.0f / 2048.0f) + 1e-6f);
}
__device__ __forceinline__ float sigm(float x) { return __builtin_amdgcn_rcpf(1.0f + __builtin_amdgcn_exp2f(-x * 1.4426950408889634f)); }
__device__ __forceinline__ void st16(void* p, const u32x4 v) { asm volatile("s_nop 1\n\tglobal_store_dwordx4 %0, %1, off sc1" :: "v"(p), "v"(v) : "memory");     }
__device__ __forceinline__ void st16(void* p, const f32x4 v) { asm volatile("s_nop 1\n\tglobal_store_dwordx4 %0, %1, off sc1" :: "v"(p), "v"(v) : "memory");     }
__device__ __forceinline__ void st16p(void* p, const u32x4 v) { *(u32x4*)p = v; }
__device__ __forceinline__ void st16p(void* p, const f32x4 v) { *(f32x4*)p = v; }
#ifndef WT_MASK
#define WT_MASK 0
#endif
#define ST16(bit, p, v) do { if ((WT_MASK >> (bit)) & 1) st16((p), (v)); else st16p((p), (v)); } while (0)
__device__ __forceinline__ u32x4 pack8bf(const f32x4 a, const f32x4 b) { u32x4 w; w.x = cvt_pk_bf16(a[0], a[1]); w.y = cvt_pk_bf16(a[2], a[3]); w.z = cvt_pk_bf16(b[0], b[1]); w.w = cvt_pk_bf16(b[2], b[3]); return w; }

struct EpiSwiGLU {
    static constexpr bool PERM = true, AFTER_DRAIN = false;
    bf16_t* O; const float* st; int ldo;
    __device__ __forceinline__ void operator()(const f32x4 (&acc)[2][2][4][2], const Unit& u, int, int, int, int, PG8_LAS unsigned char*, int) const {
        int t_ = threadIdx.x; asm volatile("" : "+v"(t_));
        const int fr = t_ & 15, fq = (t_ >> 4) & 3, wv_ = __builtin_amdgcn_readfirstlane(t_ >> 6), wr = wv_ >> 2, wc = wv_ & 3;
        const int col = u.pn * 128 + wc * 32 + 8 * fq;
#pragma unroll
        for (int ai = 0; ai < 2; ++ai)
#pragma unroll
            for (int m = 0; m < 4; ++m) {
                const int row = u.pm * BM + ai * HALF + wr * 64 + m * 16 + fr;
                const float r = row_rstd(st, row);
                f32x4 v[2];
#pragma unroll
                for (int n = 0; n < 2; ++n)
#pragma unroll
                    for (int j = 0; j < 4; ++j) { const float g = acc[ai][0][m][n][j] * r, up = acc[ai][1][m][n][j] * r; v[n][j] = g * sigm(g) * up; }
                ST16(0, O + (size_t)row * ldo + col, pack8bf(v[0], v[1]));
            }
    }
};
__device__ __forceinline__ void unpack8bf(const u32x4 w, f32x4& a, f32x4& b) {
    a[0] = __uint_as_float(w.x << 16); a[1] = __uint_as_float(w.x & 0xffff0000u); a[2] = __uint_as_float(w.y << 16); a[3] = __uint_as_float(w.y & 0xffff0000u);
    b[0] = __uint_as_float(w.z << 16); b[1] = __uint_as_float(w.z & 0xffff0000u); b[2] = __uint_as_float(w.w << 16); b[3] = __uint_as_float(w.w & 0xffff0000u);
}
template <int ALPHA2  > struct EpiResid {
    static constexpr bool PERM = true, AFTER_DRAIN = false;
    static constexpr float alpha = 0.5f * ALPHA2;
    const bf16_t* R; bf16_t* Hb; float* st;
    __device__ __forceinline__ void operator()(const f32x4 (&acc)[2][2][4][2], const Unit& u, int, int, int, int, PG8_LAS unsigned char* lds, int) const {
        int t_ = threadIdx.x; asm volatile("" : "+v"(t_));
        const int fr = t_ & 15, fq = (t_ >> 4) & 3, wv_ = __builtin_amdgcn_readfirstlane(t_ >> 6), wr = wv_ >> 2, wc = wv_ & 3;
        PG8_LAS float* P = (PG8_LAS float*)(lds + STAGE_BYTES);
#pragma unroll
        for (int ai = 0; ai < 2; ++ai)
#pragma unroll
            for (int m = 0; m < 4; ++m) {
                const int row = u.pm * BM + ai * HALF + wr * 64 + m * 16 + fr;
                float ss = 0.f;
#pragma unroll
                for (int bj = 0; bj < 2; ++bj) {
                    const size_t off = (size_t)row * 2048 + u.pn * BM + bj * HALF + wc * 32 + 8 * fq;
                    f32x4 x0, x1; unpack8bf(__builtin_nontemporal_load((const u32x4*)(R + off)), x0, x1);
                    const f32x4 v0 = x0 + acc[ai][bj][m][0] * alpha, v1 = x1 + acc[ai][bj][m][1] * alpha;
                    ST16(1, Hb + off, pack8bf(v0, v1));
                    ss += ((v0[0] * v0[0] + v0[1] * v0[1]) + (v0[2] * v0[2] + v0[3] * v0[3])) + ((v1[0] * v1[0] + v1[1] * v1[1]) + (v1[2] * v1[2] + v1[3] * v1[3]));
                }
                ss += __shfl_xor(ss, 16); ss += __shfl_xor(ss, 32);
                if (fq == 0) P[(ai * HALF + wr * 64 + m * 16 + fr) * 4 + wc] = ss;
            }
        asm volatile("s_waitcnt lgkmcnt(0)" ::: "memory"); __builtin_amdgcn_s_barrier(); asm volatile("" ::: "memory");
        if (t_ < 256) { const f32x4 p = *(const PG8_LAS f32x4*)(P + t_ * 4); st[(size_t)(u.pm * BM + t_) * 8 + u.pn] = (p[0] + p[1]) + (p[2] + p[3]); }
    }
};
struct EpiWin {
    static constexpr bool PERM = true, AFTER_DRAIN = false;
    const float* st; bf16_t* Q; size_t qkv_stride; bf16_t* U; float* out;
    __device__ __forceinline__ void operator()(const f32x4 (&acc)[2][2][4][2], const Unit& u, int, int, int, int, PG8_LAS unsigned char*, int) const {
        int t_ = threadIdx.x; asm volatile("" : "+v"(t_));
        const int fr = t_ & 15, fq = (t_ >> 4) & 3, wv_ = __builtin_amdgcn_readfirstlane(t_ >> 6), wr = wv_ >> 2, wc = wv_ & 3;
        const int pn = u.pn;
#pragma unroll
        for (int ai = 0; ai < 2; ++ai)
#pragma unroll
            for (int m = 0; m < 4; ++m) {
                const int row = u.pm * BM + ai * HALF + wr * 64 + m * 16 + fr;
                const float r = row_rstd(st, row);
                if (pn < 12) {
                    bf16_t* dst = Q + (size_t)(pn >> 2) * qkv_stride;
                    float* fo = nullptr;
                    if (pn >= 4 && row < mk::MREAL) {
                        const size_t kv = (size_t)((pn >> 2) - 1);
                        fo = row < mk::MP ? out + mk::OK_P + kv * ((size_t)mk::MP * 1024) + (size_t)row * 1024 : out + mk::OK_S + kv * ((size_t)mk::MS * 1024) + (size_t)(row - mk::MP) * 1024;
                    }
#pragma unroll
                    for (int bj = 0; bj < 2; ++bj) {
                        const int col = (pn & 3) * 256 + bj * HALF + wc * 32 + 8 * fq;
                        const f32x4 v0 = acc[ai][bj][m][0] * r, v1 = acc[ai][bj][m][1] * r;
                        ST16(2, dst + (size_t)row * 1024 + col, pack8bf(v0, v1));
                        if (fo) { __builtin_nontemporal_store(v0, (f32x4*)(fo + col)); __builtin_nontemporal_store(v1, (f32x4*)(fo + col + 4)); }
                    }
                } else {
                    const int col = (pn - 12) * 128 + wc * 32 + 8 * fq;
                    f32x4 v[2];
#pragma unroll
                    for (int n = 0; n < 2; ++n)
#pragma unroll
                        for (int j = 0; j < 4; ++j) { const float a = acc[ai][0][m][n][j] * r, g = acc[ai][1][m][n][j] * r; v[n][j] = a * sigm(g); }
                    ST16(2, U + (size_t)row * 1024 + col, pack8bf(v[0], v[1]));
                    float* co = nullptr;
                    if (row < mk::MP) { const int tt = row & 2047; if (tt >= 2018) co = out + mk::OC_P + (size_t)((row >> 11) * 30 + (tt - 2018)) * 1024; }
                    else if (row < mk::MREAL) { const int rs = row - mk::MP; co = out + mk::OC_S + (size_t)((rs >> 3) * 30 + 22 + (rs & 7)) * 1024; }
                    if (co) { __builtin_nontemporal_store(v[0], (f32x4*)(co + col)); __builtin_nontemporal_store(v[1], (f32x4*)(co + col + 4)); }
                }
            }
    }
};
struct EpiPle {
    static constexpr bool PERM = true, AFTER_DRAIN = false;
    const float* st; const bf16_t* H3; const bf16_t* PJ; bf16_t* H4;
    __device__ __forceinline__ void operator()(const f32x4 (&acc)[2][2][4][2], const Unit& u, int, int, int, int, PG8_LAS unsigned char*, int) const {
        int t_ = threadIdx.x; asm volatile("" : "+v"(t_));
        const int fr = t_ & 15, fq = (t_ >> 4) & 3, wv_ = __builtin_amdgcn_readfirstlane(t_ >> 6), wr = wv_ >> 2, wc = wv_ & 3;
#pragma unroll
        for (int ai = 0; ai < 2; ++ai)
#pragma unroll
            for (int m = 0; m < 4; ++m) {
                const int row = u.pm * BM + ai * HALF + wr * 64 + m * 16 + fr;
                const float r = row_rstd(st, row);
#pragma unroll
                for (int bj = 0; bj < 2; ++bj) {
                    const size_t off = (size_t)row * 2048 + u.pn * BM + bj * HALF + wc * 32 + 8 * fq;
                    f32x4 h[2], pj[2]; unpack8bf(__builtin_nontemporal_load((const u32x4*)(H3 + off)), h[0], h[1]); unpack8bf(__builtin_nontemporal_load((const u32x4*)(PJ + off)), pj[0], pj[1]);
                    f32x4 o[2];
#pragma unroll
                    for (int n = 0; n < 2; ++n)
#pragma unroll
                        for (int j = 0; j < 4; ++j) o[n][j] = h[n][j] + pj[n][j] * sigm(acc[ai][bj][m][n][j] * r);
                    ST16(3, H4 + off, pack8bf(o[0], o[1]));
                }
            }
    }
};
struct EpiBf16 {
    static constexpr bool PERM = true, AFTER_DRAIN = false;
    bf16_t* O;
    __device__ __forceinline__ void operator()(const f32x4 (&acc)[2][2][4][2], const Unit& u, int, int, int, int, PG8_LAS unsigned char*, int) const {
        int t_ = threadIdx.x; asm volatile("" : "+v"(t_));
        const int fr = t_ & 15, fq = (t_ >> 4) & 3, wv_ = __builtin_amdgcn_readfirstlane(t_ >> 6), wr = wv_ >> 2, wc = wv_ & 3;
#pragma unroll
        for (int ai = 0; ai < 2; ++ai)
#pragma unroll
            for (int m = 0; m < 4; ++m) {
                const int row = u.pm * BM + ai * HALF + wr * 64 + m * 16 + fr;
#pragma unroll
                for (int bj = 0; bj < 2; ++bj) {
                    const size_t off = (size_t)row * 2048 + u.pn * BM + bj * HALF + wc * 32 + 8 * fq;
                    ST16(4, O + off, pack8bf(acc[ai][bj][m][0], acc[ai][bj][m][1]));
                }
            }
    }
};
template <class Epi, class Sched, bool ALIGN_EPI = false, bool SP2 = false>
__device__ __forceinline__ void gemm_phase(PG8_LAS unsigned char* lds, const Gemm g, const Sched& S, const Epi& E) {
    int tid_l = threadIdx.x; asm volatile("" : "+v"(tid_l));
    const int tid = tid_l, wid = __builtin_amdgcn_readfirstlane(tid >> 6), lane = tid & 63, wr = wid >> 2, wc = wid & 3, fr = lane & 15, fq = lane >> 4;
    const int K = g.K, nt = K / BK;
    unsigned voffA[2], voffB[2];
#pragma unroll
    for (int i = 0; i < 2; ++i) { int R, C; stage_rc(tid * 16 + i * 8192, R, C); const int Rb = Epi::PERM ? ((R & ~31) + perm32(R & 31)) : R;
        voffA[i] = (unsigned)(R * K + C) * 2u; voffB[i] = (unsigned)(Rb * K + C) * 2u; }
    const size_t kstep = (size_t)(BK * 2);
    const size_t hstep = (size_t)HALF * K * 2;
    const size_t tstep = 2 * hstep;
    const unsigned ldsw = (unsigned)wid * 1024u;
    const int aoff = lds_byte(wr * 64 + fr, fq * 8), boff = lds_byte(wc * 32 + fr, fq * 8);
#define PG8_SA(b, h) (((b) * 2 + (h)) * HTB)
#define PG8_SB(b, h) ((4 + (b) * 2 + (h)) * HTB)
#define PG8_STAGE(bufoff, gbase, voff) do { _Pragma("unroll") for (int _i = 0; _i < 2; ++_i) \
        __builtin_amdgcn_global_load_lds((const unsigned*)((const char*)(gbase) + (voff)[_i]), (PG8_LAS unsigned*)(lds + (bufoff) + ldsw + _i * 8192), 16, 0, 0); } while (0)
#define PG8_LDA(dst, b, h) do { _Pragma("unroll") for (int m = 0; m < 4; ++m) _Pragma("unroll") for (int k = 0; k < 2; ++k) dst[m][k] = *(const PG8_LAS bf16x8*)(lds + PG8_SA(b, h) + aoff + m * 2048 + k * 1024); } while (0)
#define PG8_LDB(dst, b, h) do { _Pragma("unroll") for (int n = 0; n < 2; ++n) _Pragma("unroll") for (int k = 0; k < 2; ++k) dst[n][k] = *(const PG8_LAS bf16x8*)(lds + PG8_SB(b, h) + boff + n * 2048 + k * 1024); } while (0)
#define PG8_MMA(ai, bj, At, Bt) do { __builtin_amdgcn_s_setprio(1); _Pragma("unroll") for (int m = 0; m < 4; ++m) _Pragma("unroll") for (int n = 0; n < 2; ++n) _Pragma("unroll") for (int k = 0; k < 2; ++k) \
        acc[ai][bj][m][n] = __builtin_amdgcn_mfma_f32_16x16x32_bf16(Bt[n][k], At[m][k], acc[ai][bj][m][n], 0, 0, 0); __builtin_amdgcn_s_setprio(0); } while (0)
#define PG8_WAIT_V(n) asm volatile("s_waitcnt vmcnt(" #n ")" ::: "memory")
#define PG8_WAIT_L(n) asm volatile("s_waitcnt lgkmcnt(" #n ")" ::: "memory")
#define PG8_BAR __builtin_amdgcn_s_barrier()
#define PG8_SCHED __builtin_amdgcn_sched_barrier(0)
    Unit cur, nxt; int ui = 0;
    if (!S.next(0, cur)) return;
    f32x4 acc[2][2][4][2];
#pragma unroll
    for (int a = 0; a < 2; ++a)
#pragma unroll
        for (int b = 0; b < 2; ++b)
#pragma unroll
            for (int m = 0; m < 4; ++m)
#pragma unroll
                for (int n = 0; n < 2; ++n) acc[a][b][m][n] = (f32x4){0.f, 0.f, 0.f, 0.f};
    bf16x8 At[4][2], B0[2][2], B1[2][2];
    const char* cA = (const char*)g.A + (size_t)cur.pm * tstep; const char* cB = (const char*)g.Bt + (size_t)cur.pn * tstep;
    S.a_ready(cur);
    if constexpr (SP2) {
        PG8_STAGE(PG8_SB(0, 0), cB, voffB); PG8_STAGE(PG8_SB(0, 1), cB + hstep, voffB); PG8_STAGE(PG8_SA(0, 0), cA, voffA); PG8_STAGE(PG8_SA(0, 1), cA + hstep, voffA);
        if (wr == 1) PG8_BAR;
        PG8_WAIT_V(2); PG8_BAR;
        PG8_STAGE(PG8_SB(1, 0), cB + kstep, voffB); PG8_STAGE(PG8_SA(1, 0), cA + kstep, voffA); PG8_STAGE(PG8_SB(1, 1), cB + hstep + kstep, voffB);
        PG8_WAIT_V(6); PG8_BAR;
    } else {
        PG8_STAGE(PG8_SB(0, 0), cB, voffB); PG8_STAGE(PG8_SA(0, 0), cA, voffA); PG8_STAGE(PG8_SB(0, 1), cB + hstep, voffB); PG8_STAGE(PG8_SA(0, 1), cA + hstep, voffA);
        if (wr == 1) PG8_BAR;
        PG8_WAIT_V(4); PG8_BAR;
        PG8_STAGE(PG8_SB(1, 0), cB + kstep, voffB); PG8_STAGE(PG8_SA(1, 0), cA + kstep, voffA); PG8_STAGE(PG8_SB(1, 1), cB + hstep + kstep, voffB);
        PG8_WAIT_V(6); PG8_BAR;
    }
    for (;;) {
        const bool has_next = S.next(ui + 1, nxt);
        const char* nA = has_next ? (const char*)g.A + (size_t)nxt.pm * tstep : cA; const char* nB = has_next ? (const char*)g.Bt + (size_t)nxt.pn * tstep : cB;
        for (int t = 0; t < nt; t += 2) {
            const bool last = (t == nt - 2);
            const char* a1 = cA + (size_t)(t + 1) * kstep;
            const char* a2 = last ? nA : cA + (size_t)(t + 2) * kstep; const char* b2 = last ? nB : cB + (size_t)(t + 2) * kstep;
            const char* a3 = a2 + kstep; const char* b3 = b2 + kstep;
            if (last && has_next) S.a_ready(nxt);
            if constexpr (SP2) {
            PG8_LDB(B0, 0, 0); PG8_LDB(B1, 0, 1); PG8_SCHED; PG8_LDA(At, 0, 0); PG8_STAGE(PG8_SA(1, 1), a1 + hstep, voffA);
            PG8_WAIT_V(8); PG8_WAIT_L(0); PG8_BAR; PG8_MMA(0, 0, At, B0); PG8_MMA(0, 1, At, B1); PG8_BAR; PG8_SCHED;
            PG8_LDA(At, 0, 1); PG8_STAGE(PG8_SB(0, 0), b2, voffB); PG8_STAGE(PG8_SB(0, 1), b2 + hstep, voffB); PG8_STAGE(PG8_SA(0, 0), a2, voffA);
            PG8_WAIT_V(8); PG8_WAIT_L(0); PG8_BAR; PG8_MMA(1, 0, At, B0); PG8_MMA(1, 1, At, B1); PG8_BAR; PG8_SCHED;
            PG8_LDB(B0, 1, 0); PG8_LDB(B1, 1, 1); PG8_SCHED; PG8_LDA(At, 1, 0); PG8_STAGE(PG8_SA(0, 1), a2 + hstep, voffA);
            PG8_WAIT_V(8); PG8_WAIT_L(0); PG8_BAR; PG8_MMA(0, 0, At, B0); PG8_MMA(0, 1, At, B1); PG8_BAR; PG8_SCHED;
            PG8_LDA(At, 1, 1); PG8_STAGE(PG8_SB(1, 0), b3, voffB); PG8_STAGE(PG8_SB(1, 1), b3 + hstep, voffB); PG8_STAGE(PG8_SA(1, 0), a3, voffA);
            PG8_WAIT_V(8); PG8_WAIT_L(0); PG8_BAR; PG8_MMA(1, 0, At, B0); PG8_MMA(1, 1, At, B1); PG8_BAR; PG8_SCHED;
            } else {
            PG8_LDB(B0, 0, 0); PG8_SCHED; PG8_LDA(At, 0, 0); PG8_STAGE(PG8_SA(1, 1), a1 + hstep, voffA);
            PG8_WAIT_L(8); PG8_BAR; PG8_WAIT_L(0); PG8_MMA(0, 0, At, B0); PG8_BAR; PG8_SCHED;
            PG8_LDB(B1, 0, 1); PG8_STAGE(PG8_SB(0, 0), b2, voffB);
            PG8_BAR; PG8_WAIT_L(0); PG8_MMA(0, 1, At, B1); PG8_BAR;
            PG8_LDA(At, 0, 1); PG8_STAGE(PG8_SA(0, 0), a2, voffA);
            PG8_BAR; PG8_WAIT_L(0); PG8_MMA(1, 0, At, B0); PG8_BAR; PG8_SCHED;
            PG8_STAGE(PG8_SB(0, 1), b2 + hstep, voffB);
            PG8_WAIT_V(6); PG8_BAR; PG8_MMA(1, 1, At, B1); PG8_BAR;
            PG8_LDB(B0, 1, 0); PG8_SCHED; PG8_LDA(At, 1, 0); PG8_STAGE(PG8_SA(0, 1), a2 + hstep, voffA);
            PG8_WAIT_L(8); PG8_BAR; PG8_WAIT_L(0); PG8_MMA(0, 0, At, B0); PG8_BAR; PG8_SCHED;
            PG8_LDB(B1, 1, 1); PG8_STAGE(PG8_SB(1, 0), b3, voffB);
            PG8_BAR; PG8_WAIT_L(0); PG8_MMA(0, 1, At, B1); PG8_BAR;
            PG8_LDA(At, 1, 1); PG8_STAGE(PG8_SA(1, 0), a3, voffA);
            PG8_BAR; PG8_WAIT_L(0); PG8_MMA(1, 0, At, B0); PG8_BAR; PG8_SCHED;
            PG8_STAGE(PG8_SB(1, 1), b3 + hstep, voffB);
            PG8_WAIT_V(6); PG8_BAR; PG8_MMA(1, 1, At, B1); PG8_BAR;
            }
        }
        if constexpr (ALIGN_EPI) { if (wr == 0) PG8_BAR; }
        if constexpr (!Epi::AFTER_DRAIN) { E(acc, cur, wr, wc, fr, fq, lds, tid); S.done(cur); }
        if (!has_next) break;
#pragma unroll
        for (int a = 0; a < 2; ++a)
#pragma unroll
            for (int b = 0; b < 2; ++b)
#pragma unroll
                for (int m = 0; m < 4; ++m)
#pragma unroll
                    for (int n = 0; n < 2; ++n) acc[a][b][m][n] = (f32x4){0.f, 0.f, 0.f, 0.f};
        cur = nxt; cA = nA; cB = nB; ++ui;
        if constexpr (ALIGN_EPI) { if (wr == 1) PG8_BAR; }
    }
    PG8_WAIT_V(0);
    if constexpr (!ALIGN_EPI) { if (wr == 0) PG8_BAR; }
    PG8_BAR;
    if constexpr (Epi::AFTER_DRAIN) { E.fused(acc, cur, wr, wc, fr, fq, lds, wid, lane); S.done(cur); }
#undef PG8_SA
#undef PG8_SB
#undef PG8_STAGE
#undef PG8_LDA
#undef PG8_LDB
#undef PG8_MMA
#undef PG8_WAIT_V
#undef PG8_WAIT_L
#undef PG8_BAR
#undef PG8_SCHED
}
}
#define GAS __attribute__((address_space(1)))
#define LAS __attribute__((address_space(3)))
typedef unsigned short bf16;
typedef unsigned v4u __attribute__((ext_vector_type(4)));
typedef float f32x4 __attribute__((ext_vector_type(4)));
typedef short bf16x8 __attribute__((ext_vector_type(8)));
typedef GAS unsigned gu32;
typedef GAS unsigned long long gu64;
#define RLX_AGENT __ATOMIC_RELAXED, __HIP_MEMORY_SCOPE_AGENT
#define LDS_WAIT() asm volatile("s_waitcnt lgkmcnt(0)" ::: "memory")
#define VM_WAIT() asm volatile("s_waitcnt vmcnt(0)" ::: "memory")
__device__ __forceinline__ unsigned long long rt() { return __builtin_amdgcn_s_memrealtime(); }
__device__ __forceinline__ unsigned f2bf(float f) { unsigned u = __builtin_bit_cast(unsigned, f); return (u + 0x7fffu + ((u >> 16) & 1u)) >> 16; }
__device__ __forceinline__ unsigned pk2(float lo, float hi) { return f2bf(lo) | (f2bf(hi) << 16); }

#define XB_TMO      128
#define XB_XCNT(j)  (256  + 64 * (j))
#define XB_XSUB(j)  (1280 + 64 * (j))
#define XB_XGEN(j)  (2304 + 64 * (j))
#define XB_TOP      3328
#define XB_TOPGEN   3392
#define XCD_BAR_WORDS 3456
#define XB_SPIN_CAP (1u << 18)

__device__ __forceinline__ unsigned xb_ld(unsigned* p)              { return __hip_atomic_load(p, __ATOMIC_RELAXED, __HIP_MEMORY_SCOPE_AGENT); }
__device__ __forceinline__ unsigned xb_add(unsigned* p, unsigned v) { return __hip_atomic_fetch_add(p, v, __ATOMIC_RELAXED, __HIP_MEMORY_SCOPE_AGENT); }
__device__ __forceinline__ unsigned xb_xcc_id() { return (unsigned)__builtin_amdgcn_s_getreg((3 << 11) | 20) & 0xFu; }
#define XB_SPIN(cond, bar) do { unsigned _sp = 0; while (cond) { __builtin_amdgcn_s_sleep(1); \
    if ((++_sp & 255u) == 0u) { if (xb_ld(&(bar)[XB_TMO])) break; if (_sp > XB_SPIN_CAP) { atomicAdd(&(bar)[XB_TMO], 1u); break; } } } } while (0)

struct XcdBarrier {
    unsigned* bar; unsigned x;
    volatile LAS unsigned* st;
};

__device__ __forceinline__ XcdBarrier xcd_barrier_post(unsigned* bar, volatile LAS unsigned* st) {
    XcdBarrier b; b.bar = bar; b.x = xb_xcc_id(); b.st = st;
    if (threadIdx.x == 0) (void)xb_add(&bar[XB_XCNT(b.x)], 1u);
    return b;
}
__device__ __forceinline__ void xcd_barrier_complete(unsigned* bar, unsigned x, unsigned& nloc, unsigned& nx) {
    const unsigned G = gridDim.x * gridDim.y * gridDim.z;
    unsigned sum, cnt, mine, sp = 0u;
    for (;;) {
        sum = 0u; cnt = 0u; mine = 0u;
#pragma unroll
        for (unsigned j = 0; j < 16; ++j) { const unsigned c = xb_ld(&bar[XB_XCNT(j)]); sum += c; cnt += (c > 0u) ? 1u : 0u; mine = (j == x) ? c : mine; }
        if (sum == G) break;
        __builtin_amdgcn_s_sleep(1);
        if ((++sp & 255u) == 0u) { if (xb_ld(&bar[XB_TMO])) break; if (sp > XB_SPIN_CAP) { atomicAdd(&bar[XB_TMO], 1u); break; } }
    }
    nloc = mine > 0u ? mine : 1u; nx = cnt > 0u ? cnt : 1u;
}

__device__ __forceinline__ void xcd_barrier(const XcdBarrier& b) {
    asm volatile("s_waitcnt vmcnt(0)" ::: "memory");
    __syncthreads();
    if (threadIdx.x == 0) {
        unsigned* bar = b.bar;
        __builtin_amdgcn_s_waitcnt(0);
        unsigned nloc = b.st[0], nx = b.st[1];
        if (nloc == 0u) { xcd_barrier_complete(bar, b.x, nloc, nx); b.st[0] = nloc; b.st[1] = nx; }
        const unsigned old = xb_add(&bar[XB_XSUB(b.x)], 1u);
        const unsigned gen = old / nloc;
        if (old + 1u == (gen + 1u) * nloc) {
            __builtin_amdgcn_fence(__ATOMIC_RELEASE, "agent");
            asm volatile("s_waitcnt vmcnt(0)" ::: "memory");
            const unsigned og = xb_add(&bar[XB_TOP], 1u);
            const unsigned tg = og / nx;
            if (og + 1u == (tg + 1u) * nx) xb_add(&bar[XB_TOPGEN], 1u);
            else XB_SPIN(xb_ld(&bar[XB_TOPGEN]) == tg, bar);
            __builtin_amdgcn_fence(__ATOMIC_ACQUIRE, "agent");
            xb_add(&bar[XB_XGEN(b.x)], 1u);
            asm volatile("s_waitcnt vmcnt(0)" ::: "memory");
        } else {
            XB_SPIN(xb_ld(&bar[XB_XGEN(b.x)]) == gen, bar);
            __builtin_amdgcn_fence(__ATOMIC_ACQUIRE, "agent");
            asm volatile("s_waitcnt vmcnt(0)" ::: "memory");
        }
    }
    __syncthreads();
}
namespace att {
typedef short bf16x8 __attribute__((ext_vector_type(8)));
typedef short s16x4 __attribute__((ext_vector_type(4)));
typedef float f32x16 __attribute__((ext_vector_type(16)));
typedef float f32x4 __attribute__((ext_vector_type(4)));
typedef unsigned u32x4 __attribute__((ext_vector_type(4)));
typedef unsigned short bf16_t;
constexpr int KVBLK = 64, QBLK = 32;
constexpr int SHM_V = KVBLK * 128 * 2, SHM_K = KVBLK * 128 * 2;
constexpr float SCALE = 0.125f, THR = 8.f;
#define KSWZ(row, colB) ((row) * 256 + ((colB) ^ (((row) & 7) << 4)))
#define SBAR() __builtin_amdgcn_sched_barrier(0)
__device__ __forceinline__ int v_st(int k, int c) { const int kk = (k & ~0xC) | ((k & 4) << 1) | ((k & 8) >> 1); return ((kk >> 3) * 4 + (c >> 5)) * 512 + ((kk & 7) * 32 + (c & 31)) * 2; }
__device__ __forceinline__ int v_rd_base(int lane) { return ((lane & 3) << 3) | (((lane >> 2) & 3) << 6) | (((lane >> 4) & 1) << 5) | (((lane >> 5) & 1) << 8); }
constexpr int v_rd_off(int d0, int ks, int half) { return d0 * 512 + ks * 4096 + half * 2048; }
__device__ __forceinline__ int crow(int r, int hi) { return (r & 3) + 8 * (r >> 2) + 4 * hi; }
__device__ __forceinline__ unsigned cvtpk(float lo, float hi) { unsigned r; asm volatile("v_cvt_pk_bf16_f32 %0, %1, %2" : "=v"(r) : "v"(lo), "v"(hi)); return r; }
__device__ __forceinline__ float bf2f(bf16_t x) { return __uint_as_float((unsigned)x << 16); }
__device__ __forceinline__ void mask_tile(f32x16& p0, f32x16& p1, int dq) {
    const float NEG = -__builtin_inff();
#pragma unroll
    for (int r = 0; r < 16; ++r) {
        const int c = (r & 3) + 8 * (r >> 2);
        if (dq - c < 0) p0[r] = NEG;
        if (dq - c - 32 < 0) p1[r] = NEG;
    }
}
__device__ __forceinline__ void partialSM(f32x16& p0, f32x16& p1, float& m_reg, float& mn, float& alpha) {
    float pmax = p0[0];
#pragma unroll
    for (int r = 1; r < 16; ++r) pmax = fmaxf(pmax, p0[r]);
#pragma unroll
    for (int r = 0; r < 16; ++r) pmax = fmaxf(pmax, p1[r]);
    { auto rr = __builtin_amdgcn_permlane32_swap(__float_as_uint(pmax), __float_as_uint(pmax), false, false);
      pmax = fmaxf(__uint_as_float(rr[0]), __uint_as_float(rr[1])); }
    constexpr float C2 = 1.4426950408889634f * SCALE;
    if (__builtin_expect(__all((pmax - m_reg) * SCALE <= THR), 1)) { mn = m_reg; alpha = 1.f; }
    else { mn = fmaxf(m_reg, pmax); alpha = __builtin_amdgcn_exp2f((m_reg - mn) * C2); m_reg = mn; }
    const float mnL = -mn * C2;
#pragma unroll
    for (int r = 0; r < 16; ++r) p0[r] = fmaf(p0[r], C2, mnL);
#pragma unroll
    for (int r = 0; r < 16; ++r) p1[r] = fmaf(p1[r], C2, mnL);
#pragma unroll
    for (int r = 0; r < 16; ++r) p0[r] = __builtin_amdgcn_exp2f(p0[r]);
}
__device__ __forceinline__ void finishSM(f32x16& p0, f32x16& p1, float alpha, float& l_reg, bf16x8& pa0, bf16x8& pa1, bf16x8& pa2, bf16x8& pa3) {
#pragma unroll
    for (int r = 0; r < 16; ++r) p1[r] = __builtin_amdgcn_exp2f(p1[r]);
    float ps = 0;
#pragma unroll
    for (int r = 0; r < 16; ++r) ps += p0[r];
#pragma unroll
    for (int r = 0; r < 16; ++r) ps += p1[r];
    { auto rr = __builtin_amdgcn_permlane32_swap(__float_as_uint(ps), __float_as_uint(ps), false, false);
      ps = __uint_as_float(rr[0]) + __uint_as_float(rr[1]); }
    l_reg = l_reg * alpha + ps;
#define PK4(P, B_, OUT) do { unsigned a0 = cvtpk(P[B_+0], P[B_+1]), a1 = cvtpk(P[B_+2], P[B_+3]);                          \
        unsigned b0 = cvtpk(P[B_+4], P[B_+5]), b1 = cvtpk(P[B_+6], P[B_+7]);                                             \
        auto r0 = __builtin_amdgcn_permlane32_swap(a0, b0, false, false); auto r1 = __builtin_amdgcn_permlane32_swap(a1, b1, false, false); \
        u32x4 w = {r0[0], r1[0], r0[1], r1[1]}; OUT = *reinterpret_cast<bf16x8*>(&w); } while (0)
    PK4(p0, 0, pa0); PK4(p0, 8, pa1); PK4(p1, 0, pa2); PK4(p1, 8, pa3);
#undef PK4
}
template <int KB>
__device__ __forceinline__ void qkt(f32x16& p0, f32x16& p1, const char* K_lds, int r32, int hi, int moff, const bf16x8* qr, const f32x16& cb, float t0, float t1) {
#pragma unroll
    for (int r = 0; r < 16; ++r) { p0[r] = cb[r] + t0; p1[r] = cb[r] + t1; }
    const char* kb[4];
#pragma unroll
    for (int dd = 0; dd < 4; ++dd) kb[dd] = K_lds + KB * SHM_K + KSWZ(r32, (dd * 16 + hi * 8) * 2) + moff;
#pragma unroll
    for (int d0 = 0; d0 < 4; ++d0) {
        bf16x8 b0 = *reinterpret_cast<const bf16x8*>(kb[d0]);
        bf16x8 b1 = *reinterpret_cast<const bf16x8*>(kb[d0] + 32 * 256);
        p0 = __builtin_amdgcn_mfma_f32_32x32x16_bf16(b0, qr[d0], p0, 0, 0, 0);
        p1 = __builtin_amdgcn_mfma_f32_32x32x16_bf16(b1, qr[d0], p1, 0, 0, 0); }
}
template <int VB>
__device__ __forceinline__ void pv_tile(f32x16* o, int vb0, bf16x8 pa0, bf16x8 pa1, bf16x8 pa2, bf16x8 pa3) {
#define TRRD(dst, off) asm volatile("ds_read_b64_tr_b16 %0, %1 offset:%2" : "=&v"(dst) : "v"(vb0), "i"(off) : "memory")
#define PV_D0(d0) do { s16x4 l0, l1, l2, l3, h0, h1, h2, h3; constexpr int b_ = VB * SHM_V + v_rd_off(d0, 0, 0); \
        TRRD(l0, b_); TRRD(h0, b_ + 2048); TRRD(l1, b_ + 4096); TRRD(h1, b_ + 6144); TRRD(l2, b_ + 8192); TRRD(h2, b_ + 10240); TRRD(l3, b_ + 12288); TRRD(h3, b_ + 14336); \
        asm volatile("s_waitcnt lgkmcnt(0)" ::: "memory"); SBAR();   \
        o[d0] = __builtin_amdgcn_mfma_f32_32x32x16_bf16(pa0, (bf16x8){l0[0], l0[1], l0[2], l0[3], h0[0], h0[1], h0[2], h0[3]}, o[d0], 0, 0, 0);   \
        o[d0] = __builtin_amdgcn_mfma_f32_32x32x16_bf16(pa1, (bf16x8){l1[0], l1[1], l1[2], l1[3], h1[0], h1[1], h1[2], h1[3]}, o[d0], 0, 0, 0);   \
        o[d0] = __builtin_amdgcn_mfma_f32_32x32x16_bf16(pa2, (bf16x8){l2[0], l2[1], l2[2], l2[3], h2[0], h2[1], h2[2], h2[3]}, o[d0], 0, 0, 0);   \
        o[d0] = __builtin_amdgcn_mfma_f32_32x32x16_bf16(pa3, (bf16x8){l3[0], l3[1], l3[2], l3[3], h3[0], h3[1], h3[2], h3[3]}, o[d0], 0, 0, 0); } while (0)
    PV_D0(0); PV_D0(1); PV_D0(2); PV_D0(3);
#undef PV_D0
#undef TRRD
}
typedef short v4i16_t __attribute__((ext_vector_type(4)));
__device__ __forceinline__ void pv_tile2(f32x16* o, int vbase, bf16x8 pa0, bf16x8 pa1, bf16x8 pa2, bf16x8 pa3) {
    typedef __attribute__((address_space(3))) v4i16_t* ldsv4;
#define TRV(off) __builtin_amdgcn_ds_read_tr16_b64_v4i16((ldsv4)(vbase + (off)))
#define CAT(lo, hi) __builtin_shufflevector(lo, hi, 0, 1, 2, 3, 4, 5, 6, 7)
#pragma unroll
    for (int d0 = 0; d0 < 4; ++d0) {
        const int b_ = v_rd_off(d0, 0, 0);
        const v4i16_t l0 = TRV(b_), h0 = TRV(b_ + 2048), l1 = TRV(b_ + 4096), h1 = TRV(b_ + 6144), l2 = TRV(b_ + 8192), h2 = TRV(b_ + 10240), l3 = TRV(b_ + 12288), h3 = TRV(b_ + 14336);
        o[d0] = __builtin_amdgcn_mfma_f32_32x32x16_bf16(pa0, CAT(l0, h0), o[d0], 0, 0, 0);
        o[d0] = __builtin_amdgcn_mfma_f32_32x32x16_bf16(pa1, CAT(l1, h1), o[d0], 0, 0, 0);
        o[d0] = __builtin_amdgcn_mfma_f32_32x32x16_bf16(pa2, CAT(l2, h2), o[d0], 0, 0, 0);
        o[d0] = __builtin_amdgcn_mfma_f32_32x32x16_bf16(pa3, CAT(l3, h3), o[d0], 0, 0, 0);
    }
#undef TRV
#undef CAT
}
#define VMW() asm volatile("s_waitcnt vmcnt(0)" ::: "memory")
__device__ __forceinline__ void attn_block(const bf16_t* QB, const bf16_t* KBp, const bf16_t* VBp, bf16_t* AO, int seq0, int P0, int h, float c1, float lam, const float* gsub, char* lds) {
    int tid_l = threadIdx.x; asm volatile("" : "+v"(tid_l));
    const int tid = tid_l, wid = __builtin_amdgcn_readfirstlane(tid >> 6), lane = tid & 63, r32 = lane & 31, hi = lane >> 5;
    const int mp = wid & 1, rg = wid >> 1;
    const int NT = (P0 + 128) / KVBLK;
    const int qlo = P0 + rg * QBLK, qm = qlo + r32 - 4 * hi;
    char* V_lds = lds; char* K_lds = lds + 2 * SHM_V;
    float* ws = (float*)(lds + 2 * SHM_V + 2 * SHM_K) + wid * 64; float* li_l = ws, * al_l = ws + 32;
    const int sr = tid >> 4, sc = (tid & 15) * 8, vst0 = v_st(sr, sc), vst1 = v_st(32 + sr, sc), kws = KSWZ(sr, sc * 2);
    const int vb0 = (int)(uintptr_t)V_lds + v_rd_base(lane);
    const bf16_t* Kh = KBp + (size_t)seq0 * 1024 + h * 128 + sc; const bf16_t* Vh = VBp + (size_t)seq0 * 1024 + h * 128 + sc;
    bf16x8 qr[4];
#pragma unroll
    for (int d0 = 0; d0 < 4; ++d0) qr[d0] = *reinterpret_cast<const bf16x8*>(QB + (size_t)(seq0 + qlo + r32) * 1024 + h * 128 + mp * 64 + d0 * 16 + hi * 8);
    f32x16 cb;
#pragma unroll
    for (int r = 0; r < 16; ++r) cb[r] = c1 * (float)crow(r, hi);
    const int moff = mp * 128;
    bf16x8 sv0[2], sv1[2], sk0[2], sk1[2];
#define SLOAD(k0, R) do { sv0[R] = *reinterpret_cast<const bf16x8*>(Vh + (size_t)((k0) + sr) * 1024); sv1[R] = *reinterpret_cast<const bf16x8*>(Vh + (size_t)((k0) + 32 + sr) * 1024); \
                          sk0[R] = *reinterpret_cast<const bf16x8*>(Kh + (size_t)((k0) + sr) * 1024); sk1[R] = *reinterpret_cast<const bf16x8*>(Kh + (size_t)((k0) + 32 + sr) * 1024); } while (0)
#define SWRITE(bf, R) do { *(bf16x8*)(V_lds + (bf) * SHM_V + vst0) = sv0[R]; *(bf16x8*)(V_lds + (bf) * SHM_V + vst1) = sv1[R]; \
                           *(bf16x8*)(K_lds + (bf) * SHM_K + kws) = sk0[R]; *(bf16x8*)(K_lds + (bf) * SHM_K + kws + 32 * 256) = sk1[R]; } while (0)
#define VMW4() asm volatile("s_waitcnt vmcnt(4)" ::: "memory")
#define TB0(t) (c1 * (float)((t) * KVBLK - P0))
#define MASKT(P0_, P1_, t) do { const int kb_ = (t) * KVBLK; if (kb_ + KVBLK - 1 > qlo) mask_tile(P0_, P1_, qm - kb_); } while (0)
#define RESC(a) do { if (__any((a) < 1.f)) { if (hi == 0) al_l[r32] = (a); asm volatile("s_waitcnt lgkmcnt(0)" ::: "memory");              \
                     _Pragma("unroll") for (int d_ = 0; d_ < 4; ++d_) _Pragma("unroll") for (int r = 0; r < 16; ++r) o[d_][r] *= al_l[crow(r, hi)]; } } while (0)
    float m_reg = -1e30f, l_reg = 0; f32x16 o[4] = {};
    f32x16 pA0, pA1, pB0, pB1; float mnA, mnB, alA, alB; bf16x8 pa0, pa1, pa2, pa3;
    SLOAD(0, 0); VMW(); SWRITE(0, 0); SBAR();
    SLOAD(KVBLK, 1); if (NT > 2) SLOAD(2 * KVBLK, 0);
    __syncthreads();
    { const float t0 = TB0(0); qkt<0>(pA0, pA1, K_lds, r32, hi, moff, qr, cb, t0, t0 + 32.f * c1); }
    MASKT(pA0, pA1, 0); partialSM(pA0, pA1, m_reg, mnA, alA);
    if (NT > 2) { VMW4(); } else { VMW(); }
    SWRITE(1, 1);
    __syncthreads();
#define HALF_STEP(PX0, PX1, mnX, alX, PY0, PY1, alY, t, KB, VB, SB, RL, RW) do {                                              \
        SBAR(); if ((t) + 2 < NT) { SLOAD(((t) + 2) * KVBLK, RL); SBAR(); }                                                    \
        { const float t0 = TB0(t); qkt<KB>(PX0, PX1, K_lds, r32, hi, moff, qr, cb, t0, t0 + 32.f * c1); }                      \
        finishSM(PY0, PY1, alY, l_reg, pa0, pa1, pa2, pa3); SBAR();                                                           \
        pv_tile<VB>(o, vb0, pa0, pa1, pa2, pa3); MASKT(PX0, PX1, (t)); partialSM(PX0, PX1, m_reg, mnX, alX);                  \
        __syncthreads();                                                                                                      \
        if ((t) + 1 < NT) { if ((t) + 2 < NT) { VMW4(); } else { VMW(); } SWRITE(SB, RW); }                                   \
        RESC(alX); __syncthreads(); } while (0)
    for (int t = 1; t + 1 < NT; t += 2) {
        HALF_STEP(pB0, pB1, mnB, alB, pA0, pA1, alA, t, 1, 0, 0, 1, 0);
        HALF_STEP(pA0, pA1, mnA, alA, pB0, pB1, alB, t + 1, 0, 1, 1, 0, 1);
    }
    SBAR(); { const float t0 = TB0(NT - 1); qkt<1>(pB0, pB1, K_lds, r32, hi, moff, qr, cb, t0, t0 + 32.f * c1); } SBAR();
    finishSM(pA0, pA1, alA, l_reg, pa0, pa1, pa2, pa3); SBAR();
    pv_tile<0>(o, vb0, pa0, pa1, pa2, pa3);
    MASKT(pB0, pB1, NT - 1); partialSM(pB0, pB1, m_reg, mnB, alB); __syncthreads(); RESC(alB);
    finishSM(pB0, pB1, alB, l_reg, pa0, pa1, pa2, pa3); SBAR(); pv_tile<1>(o, vb0, pa0, pa1, pa2, pa3);
    if (hi == 0) li_l[r32] = l_reg; asm volatile("s_waitcnt lgkmcnt(0)" ::: "memory");
#pragma unroll
    for (int r = 0; r < 16; ++r) { const float rl = __builtin_amdgcn_rcpf(li_l[crow(r, hi)]);
#pragma unroll
        for (int d0 = 0; d0 < 4; ++d0) o[d0][r] *= rl; }
    __syncthreads();
    float* X = (float*)lds + rg * 4096;
    if (mp == 1) {
#pragma unroll
        for (int d0 = 0; d0 < 4; ++d0)
#pragma unroll
            for (int r = 0; r < 16; ++r) X[(d0 * 16 + r) * 64 + lane] = o[d0][r];
    }
    __syncthreads();
    if (mp == 0) {
        float gs[4];
#pragma unroll
        for (int d0 = 0; d0 < 4; ++d0) gs[d0] = gsub[d0 * 32 + r32] * 0.8f;
#pragma unroll
        for (int r = 0; r < 16; ++r) {
            float y[4]; float ss = 0.f;
#pragma unroll
            for (int d0 = 0; d0 < 4; ++d0) { y[d0] = o[d0][r] - lam * X[(d0 * 16 + r) * 64 + lane]; ss += y[d0] * y[d0]; }
            ss += __shfl_xor(ss, 1); ss += __shfl_xor(ss, 2); ss += __shfl_xor(ss, 4); ss += __shfl_xor(ss, 8); ss += __shfl_xor(ss, 16);
            const float sc_ = __builtin_amdgcn_rsqf(ss * (1.0f / 128.0f) + 1e-6f);
            bf16_t* orow = AO + (size_t)(seq0 + qlo + crow(r, hi)) * 2048 + h * 128;
#pragma unroll
            for (int d0 = 0; d0 < 4; ++d0) { const float v = y[d0] * sc_ * gs[d0]; const float vn = __shfl_xor(v, 1);
                if ((r32 & 1) == 0) *(unsigned*)(orow + d0 * 32 + r32) = cvtpk(v, vn); }
        }
    }
    __syncthreads();
#undef SLOAD
#undef SWRITE
#undef VMW4
#undef TB0
#undef MASKT
#undef RESC
#undef HALF_STEP
}


#ifndef MK_ATT_LOCKSTEP
#define MK_ATT_LOCKSTEP 1
#endif
#ifndef MK_PV
#define MK_PV pv_tile2
#endif
__device__ __forceinline__ void attn_block_dma(const bf16_t* QB, const bf16_t* KBp, const bf16_t* VBp, bf16_t* AO, int seq0, int P0, int h, float c1, float lam, const float* gsub, char* lds) {
    typedef __attribute__((address_space(3))) unsigned char* lds3_t;
    int tid_l = threadIdx.x; asm volatile("" : "+v"(tid_l));
    const int tid = tid_l, wid = __builtin_amdgcn_readfirstlane(tid >> 6), lane = tid & 63, r32 = lane & 31, hi = lane >> 5;
    const int mp = wid & 1, rg = wid >> 1;
    const int NT = (P0 + 128) / KVBLK;
    const int qlo = P0 + rg * QBLK, qm = qlo + r32 - 4 * hi;
    constexpr int SLOT = SHM_V + SHM_K;
    float* ws = (float*)(lds + 4 * SLOT) + wid * 64; float* li_l = ws, * al_l = ws + 32;
    const lds3_t l3 = (lds3_t)lds;
    const int vb0 = (int)(uintptr_t)lds + v_rd_base(lane);
    const bf16_t* Kbase = KBp + (size_t)seq0 * 1024 + h * 128; const bf16_t* Vbase = VBp + (size_t)seq0 * 1024 + h * 128;
    bf16x8 qr[4];
#pragma unroll
    for (int d0 = 0; d0 < 4; ++d0) qr[d0] = *reinterpret_cast<const bf16x8*>(QB + (size_t)(seq0 + qlo + r32) * 1024 + h * 128 + mp * 64 + d0 * 16 + hi * 8);
    f32x16 cb;
#pragma unroll
    for (int r = 0; r < 16; ++r) cb[r] = c1 * (float)crow(r, hi);
    const int moff = mp * 128;
    int koff[2], voff[2];
#pragma unroll
    for (int i = 0; i < 2; ++i) { const int j = 2 * wid + i;
        { const int row = 4 * j + (lane >> 4), c = (lane & 15) ^ (row & 7); koff[i] = row * 1024 + c * 8; }
        { const int p = 64 * j + lane, sub = p >> 5, q = p & 31, kk = (sub >> 2) * 8 + (q >> 2), c8 = (sub & 3) * 4 + (q & 3), k = (kk & ~0xC) | ((kk & 4) << 1) | ((kk & 8) >> 1); voff[i] = k * 1024 + c8 * 8; } }
#define DMA_TILE(t) do { const int tt_ = (t) < NT ? (t) : NT - 1; const int sl_ = ((t) & 3) * SLOT + 2 * wid * 1024; \
        const bf16_t* kb_ = Kbase + (size_t)tt_ * (KVBLK * 1024); const bf16_t* vb_ = Vbase + (size_t)tt_ * (KVBLK * 1024); \
        _Pragma("unroll") for (int i = 0; i < 2; ++i) __builtin_amdgcn_global_load_lds((const unsigned*)(vb_ + voff[i]), (__attribute__((address_space(3))) unsigned*)(l3 + __builtin_amdgcn_readfirstlane(sl_ + i * 1024)), 16, 0, 0); \
        _Pragma("unroll") for (int i = 0; i < 2; ++i) __builtin_amdgcn_global_load_lds((const unsigned*)(kb_ + koff[i]), (__attribute__((address_space(3))) unsigned*)(l3 + __builtin_amdgcn_readfirstlane(sl_ + SHM_V + i * 1024)), 16, 0, 0); } while (0)
#define WAITV(N) asm volatile("s_waitcnt vmcnt(" #N ")" ::: "memory")
#define RBAR() do { asm volatile("s_waitcnt lgkmcnt(0)" ::: "memory"); __builtin_amdgcn_s_barrier(); asm volatile("" ::: "memory"); } while (0)
#define KSLOT(t) (lds + ((t) & 3) * SLOT + SHM_V)
#define VSLOT(t) (vb0 + ((t) & 3) * SLOT)
#define TB0(t) (c1 * (float)((t) * KVBLK - P0))
#define MASKT(P0_, P1_, t) do { const int kb_ = (t) * KVBLK; if (kb_ + KVBLK - 1 > qlo) mask_tile(P0_, P1_, qm - kb_); } while (0)
#define RESC(a) do { if (__any((a) < 1.f)) { if (hi == 0) al_l[r32] = (a); asm volatile("s_waitcnt lgkmcnt(0)" ::: "memory");              \
                     _Pragma("unroll") for (int d_ = 0; d_ < 4; ++d_) _Pragma("unroll") for (int r = 0; r < 16; ++r) o[d_][r] *= al_l[crow(r, hi)]; } } while (0)
    float m_reg = -1e30f, l_reg = 0; f32x16 o[4] = {};
    f32x16 pA0, pA1, pB0, pB1; float mnA, mnB, alA, alB; bf16x8 pa0, pa1, pa2, pa3;
    DMA_TILE(0); DMA_TILE(1); DMA_TILE(2); DMA_TILE(3);
    WAITV(12); RBAR();
    { const float t0 = TB0(0); qkt<0>(pA0, pA1, KSLOT(0), r32, hi, moff, qr, cb, t0, t0 + 32.f * c1); }
    MASKT(pA0, pA1, 0); partialSM(pA0, pA1, m_reg, mnA, alA);
    WAITV(8); RBAR();
#define HALF_STEP_A(PX0, PX1, mnX, alX, PY0, PY1, alY, t) do {                                                                \
        SBAR(); { const float t0_ = TB0(t); qkt<0>(PX0, PX1, KSLOT(t), r32, hi, moff, qr, cb, t0_, t0_ + 32.f * c1); }         \
        finishSM(PY0, PY1, alY, l_reg, pa0, pa1, pa2, pa3); SBAR();                                                           \
        MK_PV(o, VSLOT((t) - 1), pa0, pa1, pa2, pa3); MASKT(PX0, PX1, (t)); partialSM(PX0, PX1, m_reg, mnX, alX);              \
        WAITV(4); RESC(alX); RBAR();                                                                                          \
        DMA_TILE((t) + 3); } while (0)
#define HALF_STEP_B(PX0, PX1, mnX, alX, PY0, PY1, alY, t) do {                                                                \
        SBAR(); finishSM(PY0, PY1, alY, l_reg, pa0, pa1, pa2, pa3); SBAR();                                                   \
        { const float t0_ = TB0(t); qkt<0>(PX0, PX1, KSLOT(t), r32, hi, moff, qr, cb, t0_, t0_ + 32.f * c1); } SBAR();         \
        MASKT(PX0, PX1, (t)); partialSM(PX0, PX1, m_reg, mnX, alX); SBAR();                                                   \
        MK_PV(o, VSLOT((t) - 1), pa0, pa1, pa2, pa3);                                                                         \
        WAITV(4); RESC(alX); RBAR();                                                                                          \
        DMA_TILE((t) + 3); } while (0)
    if (MK_ATT_LOCKSTEP || wid < 4) {
        for (int t = 1; t + 1 < NT; t += 2) {
            HALF_STEP_A(pB0, pB1, mnB, alB, pA0, pA1, alA, t);
            HALF_STEP_A(pA0, pA1, mnA, alA, pB0, pB1, alB, t + 1);
        }
    } else {
        for (int t = 1; t + 1 < NT; t += 2) {
            HALF_STEP_B(pB0, pB1, mnB, alB, pA0, pA1, alA, t);
            HALF_STEP_B(pA0, pA1, mnA, alA, pB0, pB1, alB, t + 1);
        }
    }
    SBAR(); { const float t0 = TB0(NT - 1); qkt<0>(pB0, pB1, KSLOT(NT - 1), r32, hi, moff, qr, cb, t0, t0 + 32.f * c1); } SBAR();
    finishSM(pA0, pA1, alA, l_reg, pa0, pa1, pa2, pa3); SBAR();
    MK_PV(o, VSLOT(NT - 2), pa0, pa1, pa2, pa3);
    MASKT(pB0, pB1, NT - 1); partialSM(pB0, pB1, m_reg, mnB, alB); RBAR(); RESC(alB);
    finishSM(pB0, pB1, alB, l_reg, pa0, pa1, pa2, pa3); SBAR(); MK_PV(o, VSLOT(NT - 1), pa0, pa1, pa2, pa3);
    if (hi == 0) li_l[r32] = l_reg; asm volatile("s_waitcnt lgkmcnt(0)" ::: "memory");
#pragma unroll
    for (int r = 0; r < 16; ++r) { const float rl = __builtin_amdgcn_rcpf(li_l[crow(r, hi)]);
#pragma unroll
        for (int d0 = 0; d0 < 4; ++d0) o[d0][r] *= rl; }
    WAITV(0); RBAR();
    float* X = (float*)lds + rg * 4096;
    if (mp == 1) {
#pragma unroll
        for (int d0 = 0; d0 < 4; ++d0)
#pragma unroll
            for (int r = 0; r < 16; ++r) X[(d0 * 16 + r) * 64 + lane] = o[d0][r];
    }
    RBAR();
    if (mp == 0) {
        float gs[4];
#pragma unroll
        for (int d0 = 0; d0 < 4; ++d0) gs[d0] = gsub[d0 * 32 + r32] * 0.8f;
#pragma unroll
        for (int r = 0; r < 16; ++r) {
            float y[4]; float ss = 0.f;
#pragma unroll
            for (int d0 = 0; d0 < 4; ++d0) { y[d0] = o[d0][r] - lam * X[(d0 * 16 + r) * 64 + lane]; ss += y[d0] * y[d0]; }
            ss += __shfl_xor(ss, 1); ss += __shfl_xor(ss, 2); ss += __shfl_xor(ss, 4); ss += __shfl_xor(ss, 8); ss += __shfl_xor(ss, 16);
            const float sc_ = __builtin_amdgcn_rsqf(ss * (1.0f / 128.0f) + 1e-6f);
            bf16_t* orow = AO + (size_t)(seq0 + qlo + crow(r, hi)) * 2048 + h * 128;
#pragma unroll
            for (int d0 = 0; d0 < 4; ++d0) { const float v = y[d0] * sc_ * gs[d0]; const float vn = __shfl_xor(v, 1);
                if ((r32 & 1) == 0) *(unsigned*)(orow + d0 * 32 + r32) = cvtpk(v, vn); }
        }
    }
    RBAR();
#undef DMA_TILE
#undef WAITV
#undef RBAR
#undef KSLOT
#undef VSLOT
#undef TB0
#undef MASKT
#undef RESC
#undef HALF_STEP_A
#undef HALF_STEP_B
}

typedef short s16x4b __attribute__((ext_vector_type(4)));
__device__ __forceinline__ void decode_unit(int b, int chunk, const float* __restrict__ cache_k, const float* __restrict__ cache_v, const int* __restrict__ page_table,
                                            const bf16_t* QB, float* DPO, float* DPM, float* DPL, char* lds) {
    typedef __attribute__((address_space(3))) s16x4b* lds_v4p;
    int tid_l = threadIdx.x; asm volatile("" : "+v"(tid_l));
    const int tid = tid_l, h = __builtin_amdgcn_readfirstlane(tid >> 6), lane = tid & 63, n = lane & 15, g = lane >> 4;
    const int unit = b * 32 + chunk;
    bf16x8 qf[4];
    { const int mq = n >> 3, tq = n & 7;
#pragma unroll
      for (int s4 = 0; s4 < 4; ++s4) { bf16x8 z = {0, 0, 0, 0, 0, 0, 0, 0};
          if ((s4 >> 1) == mq) z = *reinterpret_cast<const bf16x8*>(QB + (size_t)(mk::MP + b * 8 + tq) * 1024 + h * 128 + s4 * 32 + 8 * g);
          qf[s4] = z; } }
    const float slope_l2 = __builtin_amdgcn_exp2f(-(float)(h + 1)) * mk::LOG2E;
    float m_run = -1e30f, l_run = 0.f; f32x4 o[8];
#pragma unroll
    for (int i = 0; i < 8; ++i) o[i] = (f32x4){0.f, 0.f, 0.f, 0.f};
    f32x4 kA[8], vA[8], kB[8], vB[8];
    const int wtok = tid >> 8, whh = (tid & 255) >> 5, wd = (tid & 31) * 4;
    int pgs[4];
#pragma unroll
    for (int i = 0; i < 4; ++i) pgs[i] = page_table[b * mk::NPAGES + chunk * 4 + i];
#define DLOADS(s, KR, VR) do { const int si_ = (s) >> 3; const int pg_ = si_ == 0 ? pgs[0] : si_ == 1 ? pgs[1] : si_ == 2 ? pgs[2] : pgs[3]; const size_t base_ = (size_t)pg_ * 131072 + (size_t)((s) & 7) * 16384 + (size_t)tid * 4; \
        _Pragma("unroll") for (int i = 0; i < 8; ++i) { KR[i] = __builtin_nontemporal_load((const f32x4*)(cache_k + base_ + i * 2048)); VR[i] = __builtin_nontemporal_load((const f32x4*)(cache_v + base_ + i * 2048)); } } while (0)
    constexpr int DROW = 272, DHEAD = 16 * DROW, DBUF = 2 * 8 * DHEAD;
    char* const wbase = lds + whh * DHEAD + wtok * DROW + wd * 2;
#define DWRITES(buf, KR, VR) do { _Pragma("unroll") for (int i = 0; i < 8; ++i) { \
        uint2 kw_, vw_; kw_.x = cvtpk(KR[i][0], KR[i][1]); kw_.y = cvtpk(KR[i][2], KR[i][3]); vw_.x = cvtpk(VR[i][0], VR[i][1]); vw_.y = cvtpk(VR[i][2], VR[i][3]); \
        *(uint2*)(wbase + (buf) * DBUF + i * 2 * DROW) = kw_; \
        *(uint2*)(wbase + (buf) * DBUF + 8 * DHEAD + i * 2 * DROW) = vw_; } } while (0)
    const int tq_ = n >> 2, tp_ = n & 3;
#define DCOMPUTE(s) do { \
            const char* Kb = lds + ((s) & 1) * DBUF + h * DHEAD + n * DROW + 16 * g; const char* Vb = lds + ((s) & 1) * DBUF + 8 * DHEAD + h * DHEAD + (4 * g + tq_) * DROW + 8 * tp_; \
            f32x4 S = (f32x4){0.f, 0.f, 0.f, 0.f}; \
            _Pragma("unroll") for (int s4 = 0; s4 < 4; ++s4) { \
                const bf16x8 a = *reinterpret_cast<const bf16x8*>(Kb + s4 * 64); \
                S = __builtin_amdgcn_mfma_f32_16x16x32_bf16(a, qf[s4], S, 0, 0, 0); } \
            const int kpos0 = (chunk * 4 + ((s) >> 3)) * mk::PAGE + ((s) & 7) * 16 - mk::PAST + 4 * g; \
            float s2[4]; \
            _Pragma("unroll") for (int r = 0; r < 4; ++r) s2[r] = S[r] * (SCALE * mk::LOG2E) + slope_l2 * (float)(kpos0 + r); \
            float mx = fmaxf(fmaxf(s2[0], s2[1]), fmaxf(s2[2], s2[3])); \
            mx = fmaxf(mx, __shfl_xor(mx, 16)); mx = fmaxf(mx, __shfl_xor(mx, 32)); \
            const float mnew = fmaxf(m_run, mx), alpha = __builtin_amdgcn_exp2f(m_run - mnew); m_run = mnew; \
            float p[4]; \
            _Pragma("unroll") for (int r = 0; r < 4; ++r) p[r] = __builtin_amdgcn_exp2f(s2[r] - mnew); \
            l_run = l_run * alpha + ((p[0] + p[1]) + (p[2] + p[3])); \
            uint2 pw; pw.x = cvtpk(p[0], p[1]); pw.y = cvtpk(p[2], p[3]); \
            const s16x4b pa = __builtin_bit_cast(s16x4b, pw); \
            if (__any(alpha < 1.f)) { \
                const float a0 = __shfl(alpha, 4 * g + 0), a1 = __shfl(alpha, 4 * g + 1), a2 = __shfl(alpha, 4 * g + 2), a3 = __shfl(alpha, 4 * g + 3); \
                _Pragma("unroll") for (int i = 0; i < 8; ++i) { o[i][0] *= a0; o[i][1] *= a1; o[i][2] *= a2; o[i][3] *= a3; } } \
            _Pragma("unroll") for (int blk = 0; blk < 8; ++blk) { \
                const s16x4b vf = __builtin_bit_cast(s16x4b, __builtin_amdgcn_ds_read_tr16_b64_v4i16((lds_v4p)(Vb + blk * 32))); \
                o[blk] = __builtin_amdgcn_mfma_f32_16x16x16bf16_1k(pa, vf, o[blk], 0, 0, 0); } } while (0)
#define VMWN(N) asm volatile("s_waitcnt vmcnt(" #N ")" ::: "memory")
    DLOADS(0, kA, vA); DLOADS(1, kB, vB);
    VMWN(16); DWRITES(0, kA, vA);
    __syncthreads();
#ifndef MK_DEC_DEPTH
#define MK_DEC_DEPTH 2
#endif
    for (int s = 0; s < 32; s += 2) {
        if (MK_DEC_DEPTH == 2) { if (s + 2 < 32) DLOADS(s + 2, kA, vA); }
        DCOMPUTE(s);
        if (MK_DEC_DEPTH == 2 && s + 2 < 32) { VMWN(16); } else { VMWN(0); }
        DWRITES(1, kB, vB);
        if (MK_DEC_DEPTH == 1) { if (s + 2 < 32) DLOADS(s + 2, kA, vA); }
        __syncthreads();
        if (MK_DEC_DEPTH == 2) { if (s + 3 < 32) DLOADS(s + 3, kB, vB); }
        DCOMPUTE(s + 1);
        if (s + 2 < 32) { if (MK_DEC_DEPTH == 2 && s + 3 < 32) { VMWN(16); } else { VMWN(0); } DWRITES(0, kA, vA); }
        if (MK_DEC_DEPTH == 1) { if (s + 3 < 32) DLOADS(s + 3, kB, vB); }
        __syncthreads();
    }
#undef VMWN
#undef DCOMPUTE
    l_run += __shfl_xor(l_run, 16); l_run += __shfl_xor(l_run, 32);
    if (g == 0) { DPM[(unit * 8 + h) * 16 + n] = m_run; DPL[(unit * 8 + h) * 16 + n] = l_run; }
#pragma unroll
    for (int blk = 0; blk < 8; ++blk)
#pragma unroll
        for (int r = 0; r < 4; ++r) DPO[((size_t)(unit * 8 + h) * 16 + (4 * g + r)) * 128 + 16 * blk + n] = o[blk][r];
#undef DLOADS
#undef DWRITES
}
__device__ __forceinline__ float wsum(float v) {
#pragma unroll
    for (int o = 1; o < 64; o <<= 1) v += __shfl_xor(v, o);
    return v;
}
__device__ __forceinline__ float row16_sum(float v) {
    v += __builtin_bit_cast(float, __builtin_amdgcn_update_dpp(0, __builtin_bit_cast(int, v), 0xB1, 0xF, 0xF, true));
    v += __builtin_bit_cast(float, __builtin_amdgcn_update_dpp(0, __builtin_bit_cast(int, v), 0x4E, 0xF, 0xF, true));
    v += __builtin_bit_cast(float, __builtin_amdgcn_update_dpp(0, __builtin_bit_cast(int, v), 0x141, 0xF, 0xF, true));
    v += __builtin_bit_cast(float, __builtin_amdgcn_update_dpp(0, __builtin_bit_cast(int, v), 0x128, 0xF, 0xF, true));
    return v;
}
__device__ __forceinline__ float wave_sum_dpp(float v) {
    v = row16_sum(v);
    const int vi = __builtin_bit_cast(int, v);
    return (__builtin_bit_cast(float, __builtin_amdgcn_readlane(vi, 0)) + __builtin_bit_cast(float, __builtin_amdgcn_readlane(vi, 16))) +
           (__builtin_bit_cast(float, __builtin_amdgcn_readlane(vi, 32)) + __builtin_bit_cast(float, __builtin_amdgcn_readlane(vi, 48)));
}
__device__ __forceinline__ void decode_combine(int item, const bf16_t* QB, const bf16_t* KBp, const bf16_t* VBp, const float* DPO, const float* DPM, const float* DPL,
                                               bf16_t* AO, float lam, const float* gsub, int lane) {
    const int b = item >> 6, h = (item >> 3) & 7, t = item & 7, row = mk::MP + b * 8 + t;
    const float slope_l2 = __builtin_amdgcn_exp2f(-(float)(h + 1)) * mk::LOG2E;
    const int mh = lane >> 5, u = lane & 31, pil = ((b * 32 + u) * 8 + h) * 16 + mh * 8 + t;
    const float pm = DPM[pil], pl = DPL[pil];
    float sn0[8], sn1[8];
#pragma unroll
    for (int m = 0; m < 2; ++m) {
        const float qv = bf2f(QB[(size_t)row * 1024 + h * 128 + m * 64 + lane]);
        float pr[8];
#pragma unroll
        for (int t2 = 0; t2 < 8; ++t2) pr[t2] = wave_sum_dpp(qv * bf2f(KBp[(size_t)(mk::MP + b * 8 + t2) * 1024 + h * 128 + m * 64 + lane]));
#pragma unroll
        for (int t2 = 0; t2 < 8; ++t2) { const float sv = pr[t2] * (SCALE * mk::LOG2E) + slope_l2 * (float)t2; if (m == 0) sn0[t2] = sv; else sn1[t2] = sv; }
    }
    float M = pm;
#pragma unroll
    for (int o_ = 1; o_ < 32; o_ <<= 1) M = fmaxf(M, __shfl_xor(M, o_));
#pragma unroll
    for (int t2 = 0; t2 < 8; ++t2) if (t2 <= t) M = fmaxf(M, mh ? sn1[t2] : sn0[t2]);
    const float w = __builtin_amdgcn_exp2f(pm - M);
    float L = pl * w;
#pragma unroll
    for (int o_ = 1; o_ < 32; o_ <<= 1) L += __shfl_xor(L, o_);
#pragma unroll
    for (int t2 = 0; t2 < 8; ++t2) if (t2 <= t) L += __builtin_amdgcn_exp2f((mh ? sn1[t2] : sn0[t2]) - M);
    float on[2][2];
#pragma unroll
    for (int m = 0; m < 2; ++m) {
        const float Mm = __builtin_bit_cast(float, __builtin_amdgcn_readlane(__builtin_bit_cast(int, M), m * 32)), Lm = __builtin_bit_cast(float, __builtin_amdgcn_readlane(__builtin_bit_cast(int, L), m * 32));
        float O0 = 0.f, O1 = 0.f;
#pragma unroll
        for (int uu = 0; uu < 32; ++uu) { const float wv = __builtin_bit_cast(float, __builtin_amdgcn_readlane(__builtin_bit_cast(int, w), m * 32 + uu));
            const float2 ov = *(const float2*)(DPO + (size_t)(((b * 32 + uu) * 8 + h) * 16 + m * 8 + t) * 128 + 2 * lane); O0 += ov.x * wv; O1 += ov.y * wv; }
#pragma unroll
        for (int t2 = 0; t2 < 8; ++t2) if (t2 <= t) { const float p = __builtin_amdgcn_exp2f((m == 0 ? sn0[t2] : sn1[t2]) - Mm);
            const unsigned vv = *(const unsigned*)(VBp + (size_t)(mk::MP + b * 8 + t2) * 1024 + h * 128 + 2 * lane);
            O0 += p * __uint_as_float(vv << 16); O1 += p * __uint_as_float(vv & 0xffff0000u); }
        const float rl = 1.0f / Lm; on[m][0] = O0 * rl; on[m][1] = O1 * rl;
    }
    const float y0 = on[0][0] - lam * on[1][0], y1 = on[0][1] - lam * on[1][1];
    const float ss = wsum(y0 * y0 + y1 * y1);
    const float sc_ = __builtin_amdgcn_rsqf(ss * (1.0f / 128.0f) + 1e-6f) * 0.8f;
    const float2 gg = *(const float2*)(gsub + 2 * lane);
    *(unsigned*)(AO + (size_t)row * 2048 + h * 128 + 2 * lane) = cvtpk(y0 * sc_ * gg.x, y1 * sc_ * gg.y);
}

__device__ __forceinline__ void conv_unit(int unit, const bf16_t* U, const float* state_conv, const float* w_dw, const float* b_dw, const float* g_cn, const float* b_cn, bf16_t* AO, char* lds) {
    int tid_l = threadIdx.x; asm volatile("" : "+v"(tid_l));
    const int tid = tid_l, wid = __builtin_amdgcn_readfirstlane(tid >> 6), lane = tid & 63;
    float* T = (float*)lds;
    const bool samp = unit >= 512;
    int grp, row0, nrows, t0 = 0, bs = 0;
    if (!samp) { grp = unit & 7; const int tile = unit >> 3; row0 = tile * 128; t0 = row0 & 2047; nrows = 158; }
    else { const int su = unit - 512; grp = su & 7; bs = su >> 3; row0 = mk::MP + bs * 8; nrows = 38; }
    const int ch = grp * 128 + 2 * lane;
    float2 w[31];
#pragma unroll
    for (int j = 0; j < 31; ++j) w[j] = *(const float2*)(w_dw + (size_t)j * 1024 + ch);
    const float2 bd = *(const float2*)(b_dw + ch), gc = *(const float2*)(g_cn + ch), bc = *(const float2*)(b_cn + ch);
    {
        f32x4 fa[5], fb[5];
#pragma unroll
        for (int it = 0; it < 5; ++it) {
            const int idx = tid + 512 * it, i = idx >> 4, c8 = (idx & 15) * 8, tau = i - 30; f32x4 va = (f32x4){0.f, 0.f, 0.f, 0.f}, vb = va;
            if (idx < nrows * 16) {
                if (samp && tau < 0) { const float* sp = state_conv + (size_t)(bs * 30 + 30 + tau) * 1024 + grp * 128 + c8; va = *(const f32x4*)sp; vb = *(const f32x4*)(sp + 4); }
                else if (samp || t0 + tau >= 0) { const u32x4 w_ = *(const u32x4*)(U + (size_t)(row0 + tau) * 1024 + grp * 128 + c8);
                    va = (f32x4){__uint_as_float(w_.x << 16), __uint_as_float(w_.x & 0xffff0000u), __uint_as_float(w_.y << 16), __uint_as_float(w_.y & 0xffff0000u)};
                    vb = (f32x4){__uint_as_float(w_.z << 16), __uint_as_float(w_.z & 0xffff0000u), __uint_as_float(w_.w << 16), __uint_as_float(w_.w & 0xffff0000u)}; }
            }
            fa[it] = va; fb[it] = vb;
        }
#pragma unroll
        for (int it = 0; it < 5; ++it) { const int idx = tid + 512 * it; if (idx < nrows * 16) { float* d = T + (idx >> 4) * 128 + (idx & 15) * 8; *(f32x4*)d = fa[it]; *(f32x4*)(d + 4) = fb[it]; } }
    }
    __syncthreads();
    const int ngrp = samp ? 1 : 4, tokb = samp ? wid : wid * 16;
    for (int k4 = 0; k4 < ngrp; ++k4) {
        float a0[4], a1[4];
#pragma unroll
        for (int q = 0; q < 4; ++q) { a0[q] = bd.x; a1[q] = bd.y; }
#pragma unroll
        for (int j = 0; j < 34; ++j) {
            const float2 x = *(const float2*)(T + (tokb + 4 * k4 + j) * 128 + 2 * lane);
#pragma unroll
            for (int q = 0; q < 4; ++q) if (j - q >= 0 && j - q < 31) { a0[q] = fmaf(w[j - q].x, x.x, a0[q]); a1[q] = fmaf(w[j - q].y, x.y, a1[q]); }
        }
#pragma unroll
        for (int q = 0; q < 4; ++q) {
            if (samp && q > 0) break;
            const int tt = tokb + 4 * k4 + q;
            const float mean = wave_sum_dpp(a0[q] + a1[q]) * (1.0f / 128.0f);
            const float d0 = a0[q] - mean, d1 = a1[q] - mean;
            const float rs = __builtin_amdgcn_rsqf(wave_sum_dpp(d0 * d0 + d1 * d1) * (1.0f / 128.0f) + 1e-5f);
            const float y0 = d0 * rs * gc.x + bc.x, y1 = d1 * rs * gc.y + bc.y;
            const float o0 = y0 * __builtin_amdgcn_rcpf(1.0f + __builtin_amdgcn_exp2f(-y0 * mk::LOG2E)), o1 = y1 * __builtin_amdgcn_rcpf(1.0f + __builtin_amdgcn_exp2f(-y1 * mk::LOG2E));
            *(unsigned*)(AO + (size_t)(row0 + tt) * 2048 + 1024 + ch) = cvtpk(o0, o1);
        }
    }
    __syncthreads();
}
#undef VMW
#undef SBAR
#undef KSWZ
}
namespace sk {
typedef short bf16x8 __attribute__((ext_vector_type(8)));
typedef float f32x4 __attribute__((ext_vector_type(4)));
typedef unsigned short bf16_t;
__device__ __forceinline__ float ssq8(const bf16x8 a) {
    const uint4 w = __builtin_bit_cast(uint4, a); float s = 0.f;
    { const float lo = __uint_as_float(w.x << 16), hi = __uint_as_float(w.x & 0xffff0000u); s = fmaf(lo, lo, s); s = fmaf(hi, hi, s); }
    { const float lo = __uint_as_float(w.y << 16), hi = __uint_as_float(w.y & 0xffff0000u); s = fmaf(lo, lo, s); s = fmaf(hi, hi, s); }
    { const float lo = __uint_as_float(w.z << 16), hi = __uint_as_float(w.z & 0xffff0000u); s = fmaf(lo, lo, s); s = fmaf(hi, hi, s); }
    { const float lo = __uint_as_float(w.w << 16), hi = __uint_as_float(w.w & 0xffff0000u); s = fmaf(lo, lo, s); s = fmaf(hi, hi, s); }
    return s;
}
__device__ __forceinline__ unsigned short f2bf(float f) { unsigned u = __builtin_bit_cast(unsigned, f); return (unsigned short)((u + 0x7fffu + ((u >> 16) & 1u)) >> 16); }
__device__ __forceinline__ void pos_rc(int tid, int i, int& row, int& col) { const int p = tid + 512 * i, rb = p >> 8, q = p & 255, l = q & 63; row = rb * 16 + 4 * (l >> 4) + (q >> 6); col = l & 15; }

template <int RB, int NACC, bool STATS, int K>
__device__ __forceinline__ void tile(const bf16_t* A, const bf16_t* B0, const bf16_t* B1, char* lds, float (&v)[RB / 2][NACC], float (&rs)[RB / 2]) {
    int tid_l = threadIdx.x; asm volatile("" : "+v"(tid_l));
    const int tid = tid_l, wave = __builtin_amdgcn_readfirstlane(tid >> 6), lane = tid & 63, n = lane & 15, g = lane >> 4;
    constexpr int per = (K / 32) / 8;
    constexpr int BATCH = (RB * NACC >= 8) ? 2 : (RB >= 4 ? 4 : (per > 8 ? (per + 1) / 2 : 8));
    f32x4 acc[NACC][RB]; float ssq[RB];
#pragma unroll
    for (int s = 0; s < NACC; ++s)
#pragma unroll
        for (int rb = 0; rb < RB; ++rb) acc[s][rb] = (f32x4){0.f, 0.f, 0.f, 0.f};
#pragma unroll
    for (int rb = 0; rb < RB; ++rb) ssq[rb] = 0.f;
    const bf16_t* ap = A + (size_t)n * K + 8 * g + (size_t)wave * per * 32;
    const bf16_t* bp0 = B0 + (size_t)n * K + 8 * g + (size_t)wave * per * 32;
    const bf16_t* bp1 = (NACC == 2 ? B1 : B0) + (size_t)n * K + 8 * g + (size_t)wave * per * 32;
#pragma unroll
    for (int k0 = 0; k0 < per; k0 += BATCH) {
        bf16x8 bf[BATCH][NACC], af[BATCH][RB];
#pragma unroll
        for (int j = 0; j < BATCH; ++j) if (k0 + j < per) {
            bf[j][0] = *reinterpret_cast<const bf16x8*>(bp0 + (k0 + j) * 32);
            if (NACC == 2) bf[j][NACC - 1] = *reinterpret_cast<const bf16x8*>(bp1 + (k0 + j) * 32);
#pragma unroll
            for (int rb = 0; rb < RB; ++rb) af[j][rb] = *reinterpret_cast<const bf16x8*>(ap + (size_t)rb * 16 * K + (k0 + j) * 32);
        }
        __builtin_amdgcn_sched_barrier(0);
#pragma unroll
        for (int j = 0; j < BATCH; ++j) if (k0 + j < per) {
#pragma unroll
            for (int rb = 0; rb < RB; ++rb) {
                if (STATS) ssq[rb] += ssq8(af[j][rb]);
#pragma unroll
                for (int s = 0; s < NACC; ++s) acc[s][rb] = __builtin_amdgcn_mfma_f32_16x16x32_bf16(af[j][rb], bf[j][s], acc[s][rb], 0, 0, 0);
            }
        }
        __builtin_amdgcn_sched_barrier(0);
    }
    float* red = (float*)lds; float* redS = red + 8 * NACC * RB * 256;
#pragma unroll
    for (int s = 0; s < NACC; ++s)
#pragma unroll
        for (int rb = 0; rb < RB; ++rb)
#pragma unroll
            for (int r = 0; r < 4; ++r) red[(((wave * NACC + s) * RB + rb) * 4 + r) * 64 + lane] = acc[s][rb][r];
    if (STATS) {
#pragma unroll
        for (int rb = 0; rb < RB; ++rb) { float q = ssq[rb]; q += __shfl_xor(q, 16); q += __shfl_xor(q, 32); if (g == 0) redS[wave * (RB * 16) + rb * 16 + n] = q; }
    }
    __syncthreads();
#pragma unroll
    for (int i = 0; i < RB / 2; ++i) {
        const int p = tid + 512 * i, rb = p >> 8, q = p & 255;
#pragma unroll
        for (int s = 0; s < NACC; ++s) { float sum = 0.f;
#pragma unroll
            for (int w = 0; w < 8; ++w) sum += red[((w * NACC + s) * RB + rb) * 256 + q];
            v[i][s] = sum; }
        if (STATS) { const int l = q & 63, rl = rb * 16 + 4 * (l >> 4) + (q >> 6); float sum = 0.f;
#pragma unroll
            for (int w = 0; w < 8; ++w) sum += redS[w * (RB * 16) + rl];
            rs[i] = __builtin_amdgcn_rsqf(sum / (float)K + 1e-6f); }
        else rs[i] = 1.f;
    }
    __syncthreads();
}
__device__ __forceinline__ float sigm(float x) { return __builtin_amdgcn_rcpf(1.0f + __builtin_amdgcn_exp2f(-x * 1.4426950408889634f)); }

#define SK_DEAL(nchunks, slack) int c0_, cs_; if ((slack) && G == 256) { c0_ = bx - 128; cs_ = 128; } else { c0_ = bx; cs_ = G; } for (int c = c0_; c >= 0 && c < (nchunks); c += cs_)

__device__ __forceinline__ void swiglu_phase(const bf16_t* A, const bf16_t* Wt, bf16_t* ACTs, int bx, int G, char* lds) {
    SK_DEAL(352, true) {
        const int col0 = c * 16; const bf16_t* Bg = Wt + (size_t)(256 * (col0 >> 7) + (col0 & 127)) * 2048;
        float v[2][2], rs[2]; tile<4, 2, true, 2048>(A, Bg, Bg + (size_t)128 * 2048, lds, v, rs);
#pragma unroll
        for (int i = 0; i < 2; ++i) { int row, col; pos_rc(threadIdx.x, i, row, col); const float g = v[i][0] * rs[i], u = v[i][1] * rs[i];
            ACTs[(size_t)row * 5632 + col0 + col] = f2bf(g * sigm(g) * u); }
    }
}
template <int ALPHA2, int K>
__device__ __forceinline__ void resid_phase(const bf16_t* A, const bf16_t* Wt, const bf16_t* resid, bf16_t* Hbs, int bx, int G, char* lds) {
    SK_DEAL(256, false) {
        const int col0 = (c & 127) * 16, row0 = (c >> 7) * 32;
        int row, col; pos_rc(threadIdx.x, 0, row, col); const size_t o = (size_t)(row0 + row) * 2048 + col0 + col;
        const bf16_t rv = resid[o];
        float v[1][1], rs[1]; tile<2, 1, false, K>(A + (size_t)row0 * K, Wt + (size_t)col0 * K, nullptr, lds, v, rs);
        Hbs[o] = f2bf(__uint_as_float((unsigned)rv << 16) + (0.5f * ALPHA2) * v[0][0]);
    }
}
__device__ __forceinline__ void win_phase(const bf16_t* A, const bf16_t* Wt, bf16_t* Qs, size_t qkv_stride, bf16_t* Us, float* out, int bx, int G, char* lds) {
    SK_DEAL(256, true) {
        if (c < 192) {
            const int col0 = c * 16; float v[2][1], rs[2]; tile<4, 1, true, 2048>(A, Wt + (size_t)col0 * 2048, nullptr, lds, v, rs);
            const int t = col0 >> 10, cc = col0 & 1023;
#pragma unroll
            for (int i = 0; i < 2; ++i) { int row, col; pos_rc(threadIdx.x, i, row, col); const float x = v[i][0] * rs[i];
                Qs[(size_t)t * qkv_stride + (size_t)row * 1024 + cc + col] = f2bf(x);
                if (t) out[mk::OK_S + (size_t)(t - 1) * (mk::MS * 1024) + (size_t)row * 1024 + cc + col] = x; }
        } else {
            const int j0 = (c - 192) * 16; const bf16_t* Ba = Wt + (size_t)(3072 + 256 * (j0 >> 7) + (j0 & 127)) * 2048;
            float v[2][2], rs[2]; tile<4, 2, true, 2048>(A, Ba, Ba + (size_t)128 * 2048, lds, v, rs);
#pragma unroll
            for (int i = 0; i < 2; ++i) { int row, col; pos_rc(threadIdx.x, i, row, col); const float u = v[i][0] * rs[i] * sigm(v[i][1] * rs[i]);
                Us[(size_t)row * 1024 + j0 + col] = f2bf(u);
                out[mk::OC_S + (size_t)((row >> 3) * 30 + 22 + (row & 7)) * 1024 + j0 + col] = u; }
        }
    }
}
__device__ __forceinline__ void ple_phase(const bf16_t* H3b, const bf16_t* Wg, const bf16_t* Pb, const bf16_t* Wp, bf16_t* H4s, int bx, int G, char* lds) {
    SK_DEAL(256, false) {
        const int col0 = (c & 127) * 16, row0 = (c >> 7) * 32;
        float vg[1][1], rg[1], vp[1][1], rp[1];
        tile<2, 1, true, 2048>(H3b + (size_t)row0 * 2048, Wg + (size_t)col0 * 2048, nullptr, lds, vg, rg);
        tile<2, 1, false, 256>(Pb + (size_t)row0 * 256, Wp + (size_t)col0 * 256, nullptr, lds, vp, rp);
        int row, col; pos_rc(threadIdx.x, 0, row, col); const size_t o = (size_t)(row0 + row) * 2048 + col0 + col;
        H4s[o] = f2bf(__uint_as_float((unsigned)H3b[o] << 16) + vp[0][0] * sigm(vg[0][0] * rg[0]));
    }
}
#undef SK_DEAL
}
namespace mk {
constexpr int NWAVES = 8;
constexpr size_t MiB = 1u << 20;
constexpr size_t WS_CTL = 0, CTL_ZERO_BYTES = 1 * MiB;
constexpr size_t WS_W1T = 1 * MiB;
constexpr size_t WS_W2T = WS_W1T + 44 * MiB;
constexpr size_t WS_WINT = WS_W2T + 22 * MiB;
constexpr size_t WS_WOT = WS_WINT + 20 * MiB;
constexpr size_t WS_W3T = WS_WOT + 8 * MiB;
constexpr size_t WS_W4T = WS_W3T + 44 * MiB;
constexpr size_t WS_WPGT = WS_W4T + 22 * MiB;
constexpr size_t WS_WPPT = WS_WPGT + 8 * MiB;
constexpr size_t WS_XB = WS_WPPT + 1 * MiB;
constexpr size_t WS_PB = WS_XB + 33 * MiB;
constexpr size_t WS_ACT = WS_PB + 5 * MiB;
constexpr size_t WS_H1B = WS_ACT + 91 * MiB;
constexpr size_t WS_QB = WS_H1B + 33 * MiB;
constexpr size_t WS_KB = WS_QB + 17 * MiB;
constexpr size_t WS_VB = WS_KB + 17 * MiB;
constexpr size_t WS_U = WS_VB + 17 * MiB;
constexpr size_t WS_AO = WS_U + 33 * MiB;
constexpr size_t WS_H2B = WS_AO + 33 * MiB;
constexpr size_t WS_H3B = WS_H2B + 33 * MiB;
constexpr size_t WS_PJ = WS_H3B + 33 * MiB;
constexpr size_t WS_H4 = WS_PJ + 33 * MiB;
constexpr size_t WS_ST1 = WS_H4 + 66 * MiB;
constexpr size_t WS_ST2 = WS_ST1 + 1 * MiB;
constexpr size_t WS_ST3 = WS_ST2 + 1 * MiB;
constexpr size_t WS_ST4 = WS_ST3 + 1 * MiB;
constexpr size_t WS_DPO = WS_ST4 + 1 * MiB;
constexpr size_t WS_DPM = WS_DPO + 16 * MiB;
constexpr size_t WS_DPL = WS_DPM + 1 * MiB;
constexpr size_t WS_END = WS_DPL + 1 * MiB;
static_assert((size_t)MPAD * 2048 * 2 <= 33 * MiB && (size_t)MPAD * 5632 * 2 <= 91 * MiB && (size_t)MPAD * 2048 * 4 <= 66 * MiB && (size_t)MPAD * 1024 * 2 <= 17 * MiB, "ws map");
constexpr int CW_BAR = 4096;
constexpr int RING_BYTES = 131072, PST_OFF = RING_BYTES, MISC_OFF = 143360, LDS_BYTES = 147456;
static_assert(8 * 16896 <= MISC_OFF && 2 * 69632 <= MISC_OFF, "phase scratch below the control words");
}


namespace mk {
__device__ __forceinline__ float wave_sum(float v) {
#pragma unroll
    for (int o = 1; o < 64; o <<= 1) v += __shfl_xor(v, o);
    return v;
}
struct TrD { const float* src; const float* gain; bf16* dst; int N, K; };
__device__ __forceinline__ TrD tr_desc(const float* W, const float* gain, int K, int N, bf16* WT, int mode, int item) {
    const int nblk = N / 32, kb = item / nblk, nb = item % nblk, k0 = 64 * kb, n0 = 32 * nb;
    int dr = n0;
    if (mode == 1 || mode == 2) dr = 256 * (n0 >> 7) + 128 * (mode - 1) + (n0 & 127);
    else if (mode == 3 && n0 >= 3072) { const int j = n0 - 3072, half = j >> 10, jj = j & 1023; dr = 3072 + 256 * (jj >> 7) + 128 * half + (jj & 127); }
    TrD d; d.src = W + (size_t)k0 * N + n0; d.gain = gain ? gain + k0 : nullptr; d.dst = WT + (size_t)dr * K + k0; d.N = N; d.K = K; return d;
}
__device__ __forceinline__ void tr_load(const TrD& d, f32x4 (&t)[8], int lane) {
    const float* src = d.src + (size_t)(lane >> 3) * d.N + (lane & 7) * 4;
#pragma unroll
    for (int i = 0; i < 8; ++i) t[i] = __builtin_nontemporal_load((const GAS f32x4*)(src + (size_t)(8 * i) * d.N));
}
__device__ __forceinline__ void tr_store(const TrD& d, const f32x4 (&t)[8], LAS float* scr, int lane) {
    const int c = lane & 7;
    float gv[8];
#pragma unroll
    for (int j = 0; j < 8; ++j) gv[j] = d.gain ? d.gain[8 * c + j] : 1.0f;
#pragma unroll
    for (int i = 0; i < 8; ++i) { LAS float* p = scr + (8 * i + (lane >> 3)) * 33 + (lane & 7) * 4; p[0] = t[i].x; p[1] = t[i].y; p[2] = t[i].z; p[3] = t[i].w; }
    LDS_WAIT(); asm volatile("" ::: "memory");
#pragma unroll
    for (int j = 0; j < 4; ++j) { const int n = (lane >> 3) + 8 * j; const LAS float* s_ = scr + (8 * c) * 33 + n;
        v4u o; o.x = pk2(s_[0 * 33] * gv[0], s_[1 * 33] * gv[1]); o.y = pk2(s_[2 * 33] * gv[2], s_[3 * 33] * gv[3]); o.z = pk2(s_[4 * 33] * gv[4], s_[5 * 33] * gv[5]); o.w = pk2(s_[6 * 33] * gv[6], s_[7 * 33] * gv[7]);
        *(GAS v4u*)(d.dst + (size_t)n * d.K + 8 * c) = o; }
    LDS_WAIT(); asm volatile("" ::: "memory");
}
#define TR_STREAM(NIT, w0, ws, DESC) do { LAS float* scrA_ = (LAS float*)(ldsl + wave * 16896); LAS float* scrB_ = scrA_ + 64 * 33;     \
    for (int it_ = (w0); it_ >= 0 && it_ < (NIT); it_ += 2 * (ws)) { const bool hb_ = it_ + (ws) < (NIT); const TrD da_ = DESC(it_); const TrD db_ = DESC(hb_ ? it_ + (ws) : it_); \
        f32x4 ta_[8], tb_[8]; tr_load(da_, ta_, lane); if (hb_) tr_load(db_, tb_, lane); tr_store(da_, ta_, scrA_, lane); if (hb_) tr_store(db_, tb_, scrB_, lane); } } while (0)

struct Args { const void* in[32]; float* out; unsigned char* ws; int ph_lo, ph_hi; };
constexpr int N_PHASES = 11;

__global__ void __launch_bounds__(NWAVES * 64, 2) hymba_fwd(Args args) {
    extern __shared__ __attribute__((aligned(16))) unsigned char lds[];
    LAS unsigned char* ldsl = (LAS unsigned char*)lds;
    volatile LAS unsigned* MISC = (volatile LAS unsigned*)(ldsl + MISC_OFF);
#define LOCAL_IDS() int tid_l = threadIdx.x; asm volatile("" : "+v"(tid_l)); const int lane = tid_l & 63, wave = __builtin_amdgcn_readfirstlane(tid_l >> 6), gw = vcu * NWAVES + wave, NGW = G * NWAVES; (void)lane; (void)gw; (void)NGW
    const int G = gridDim.x; const int bx = blockIdx.x; const int vcu = (G % 8 == 0) ? (bx % 8) * (G / 8) + bx / 8 : bx;
#define WSP(T, off) ((T*)(args.ws + (off)))
#define INF(i) ((const float*)args.in[i])
    gu32* ctl = (gu32*)(args.ws + WS_CTL);
    float* out = args.out;
    for (int u = threadIdx.x; u < (LDS_BYTES - MISC_OFF) / 4; u += NWAVES * 64) ((LAS unsigned*)(ldsl + MISC_OFF))[u] = 0u;
    __syncthreads();
    XcdBarrier bar = xcd_barrier_post((unsigned*)(ctl + CW_BAR), MISC + 8);
    const int lo = args.ph_lo, hi = args.ph_hi;
#ifndef MK_ATTN_FN
#define MK_ATTN_FN attn_block_dma
#endif
#ifndef MK_SP2
#define MK_SP2 true
#endif
#ifndef MK_P4_NS
#define MK_P4_NS 0
#endif
#ifndef MK_P4_FS
#define MK_P4_FS 4
#endif
#ifndef MK_REP_ATT
#define MK_REP_ATT 1
#endif
#ifndef MK_REP_DEC
#define MK_REP_DEC 1
#endif
#ifndef MK_REP_CONV
#define MK_REP_CONV 1
#endif
#ifndef MK_REPEAT_MASK
#define MK_REPEAT_MASK 0
#endif
#define IN(k) (lo <= (k) && (k) < hi)
#define PH(k) if (IN(k)) for (int rep_ = 0; rep_ < (((MK_REPEAT_MASK) >> (k)) & 1) + 1; ++rep_, __syncthreads())
#ifndef MK_BAR_REPS
#define MK_BAR_REPS 1
#endif
#define GRID_BAR(k) do { if (IN(k) && IN((k) + 1)) for (int br_ = 0; br_ < MK_BAR_REPS; ++br_) xcd_barrier(bar); } while (0)

    PH(0) {
        LOCAL_IDS();
        constexpr int I_GU = 32 * 176, I_DN = 88 * 64, I_IN = 32 * 160, I_PP = 4 * 64;
        constexpr int I_SQ = 32 * 64;
        constexpr int NITEMS = 4 * I_GU + 2 * I_DN + I_IN + I_PP + 2 * I_SQ;
        constexpr int O1 = 2 * I_GU, O2 = O1 + I_DN, O3 = O2 + I_SQ, O4 = O3 + I_SQ, O5 = O4 + I_PP, O6 = O5 + I_IN, O7 = O6 + I_DN, O8 = O7 + I_GU;
#define P0_DESC(it) ((it) < I_GU ? tr_desc(INF(25), INF(24), D, FF, WSP(bf16, WS_W3T), 1, (it)) : (it) < O1 ? tr_desc(INF(26), INF(24), D, FF, WSP(bf16, WS_W3T), 2, (it) - I_GU) : \
                     (it) < O2 ? tr_desc(INF(27), nullptr, FF, D, WSP(bf16, WS_W4T), 0, (it) - O1) : \
                     (it) < O3 ? tr_desc(INF(23), nullptr, D, D, WSP(bf16, WS_WOT), 0, (it) - O2) : \
                     (it) < O4 ? tr_desc(INF(29), INF(28), D, D, WSP(bf16, WS_WPGT), 0, (it) - O3) : \
                     (it) < O5 ? tr_desc(INF(30), nullptr, DPLE, D, WSP(bf16, WS_WPPT), 0, (it) - O4) : \
                     (it) < O6 ? tr_desc(INF(13), INF(12), D, NIN, WSP(bf16, WS_WINT), 3, (it) - O5) : \
                     (it) < O7 ? tr_desc(INF(11), nullptr, FF, D, WSP(bf16, WS_W2T), 0, (it) - O6) : \
                     (it) < O8 ? tr_desc(INF(9), INF(8), D, FF, WSP(bf16, WS_W1T), 1, (it) - O7) : tr_desc(INF(10), INF(8), D, FF, WSP(bf16, WS_W1T), 2, (it) - O8))
        TR_STREAM(NITEMS, gw, NGW, P0_DESC);
#undef P0_DESC
        {
        const float* x_prompt = INF(0); const float* x_sample = INF(1); const float* p_prompt = INF(6); const float* p_sample = INF(7);
        bf16* XB = WSP(bf16, WS_XB); bf16* PB = WSP(bf16, WS_PB); float* ST1 = WSP(float, WS_ST1);
        for (int m = gw; m < MREAL; m += NGW) {
            const float* xr = m < MP ? x_prompt + (size_t)m * D : x_sample + (size_t)(m - MP) * D;
            const GAS f32x4* xv = (const GAS f32x4*)xr + lane;
            f32x4 v[8]; float s = 0.f;
#pragma unroll
            for (int j = 0; j < 8; ++j) { v[j] = __builtin_nontemporal_load(xv + 64 * j); s += (v[j].x * v[j].x + v[j].y * v[j].y) + (v[j].z * v[j].z + v[j].w * v[j].w); }
            s = wave_sum(s);
            GAS unsigned long long* o8 = (GAS unsigned long long*)(XB + (size_t)m * D) + lane;
#pragma unroll
            for (int j = 0; j < 8; ++j) o8[64 * j] = (unsigned long long)pk2(v[j].x, v[j].y) | ((unsigned long long)pk2(v[j].z, v[j].w) << 32);
            if (lane < 2) *(GAS f32x4*)(ST1 + (size_t)m * 8 + 4 * lane) = (f32x4){lane == 0 ? s : 0.f, 0.f, 0.f, 0.f};
            const float* pr = m < MP ? p_prompt + (size_t)m * DPLE : p_sample + (size_t)(m - MP) * DPLE;
            const f32x4 pv = ((const GAS f32x4*)pr)[lane];
            ((GAS unsigned long long*)(PB + (size_t)m * DPLE))[lane] = (unsigned long long)pk2(pv.x, pv.y) | ((unsigned long long)pk2(pv.z, pv.w) << 32);
        }
        const int gt = gw * 64 + lane, NGT = NGW * 64;
        const float* state_conv = INF(4);
        for (int i = gt; i < DB * 22 * 256; i += NGT) { const int bs = i / (22 * 256), rem = i % (22 * 256), rr = rem >> 8, c4 = (rem & 255) * 4;
            *(GAS f32x4*)(out + OC_S + (size_t)(bs * 30 + rr) * CW + c4) = *(const GAS f32x4*)(state_conv + (size_t)(bs * 30 + rr + 8) * CW + c4); }
        }
    }
    GRID_BAR(0);

#define PJ_HALF(hf) do { const bool slk_ = (G == 256); const int cs_ = slk_ ? (bx >= 128 ? bx - 128 + 128 * (hf) : -1) : ((hf) == 0 ? bx : -1); \
        if (cs_ >= 0) { int kple = DPLE; asm volatile("" : "+s"(kple));          \
            pg8::Gemm g{WSP(bf16, WS_PB), WSP(bf16, WS_WPPT), MP, D, kple}; pg8::StaticOrder S; S.init(MP, D, slk_ ? 256 : G, cs_); pg8::EpiBf16 E{WSP(bf16, WS_PJ)}; \
            pg8::gemm_phase<pg8::EpiBf16, pg8::StaticOrder, true, MK_SP2>(ldsl, g, S, E); } } while (0)
    PH(1) {
        { pg8::Gemm g{WSP(bf16, WS_XB), WSP(bf16, WS_W1T), MP, 2 * FF, D}; pg8::StaticOrder S; S.init(MP, 2 * FF, G, bx); pg8::EpiSwiGLU E{WSP(bf16, WS_ACT), WSP(float, WS_ST1), FF};
          pg8::gemm_phase<pg8::EpiSwiGLU, pg8::StaticOrder, true, MK_SP2>(ldsl, g, S, E); }
        sk::swiglu_phase(WSP(bf16, WS_XB) + (size_t)MP * D, WSP(bf16, WS_W1T), WSP(bf16, WS_ACT) + (size_t)MP * FF, bx, G, (char*)lds);
        PJ_HALF(0);
    }
    GRID_BAR(1);
    PH(2) {
        pg8::Gemm g{WSP(bf16, WS_ACT), WSP(bf16, WS_W2T), MP, D, FF}; pg8::StaticOrder S; S.init(MP, D, G, bx);
        pg8::EpiResid<1> E{WSP(bf16, WS_XB), WSP(bf16, WS_H1B), WSP(float, WS_ST2)};
        pg8::gemm_phase<pg8::EpiResid<1>, pg8::StaticOrder, true, MK_SP2>(ldsl, g, S, E);
        sk::resid_phase<1, FF>(WSP(bf16, WS_ACT) + (size_t)MP * FF, WSP(bf16, WS_W2T), WSP(bf16, WS_XB) + (size_t)MP * D, WSP(bf16, WS_H1B) + (size_t)MP * D, bx, G, (char*)lds);
    }
    GRID_BAR(2);
    PH(3) {
        pg8::Gemm g{WSP(bf16, WS_H1B), WSP(bf16, WS_WINT), MP, NIN, D}; pg8::StaticOrder S; S.init(MP, NIN, G, bx);
        pg8::EpiWin E{WSP(float, WS_ST2), WSP(bf16, WS_QB), (WS_KB - WS_QB) / 2, WSP(bf16, WS_U), out};
        pg8::gemm_phase<pg8::EpiWin, pg8::StaticOrder, true, MK_SP2>(ldsl, g, S, E);
        sk::win_phase(WSP(bf16, WS_H1B) + (size_t)MP * D, WSP(bf16, WS_WINT), WSP(bf16, WS_QB) + (size_t)MP * 1024, (WS_KB - WS_QB) / 2, WSP(bf16, WS_U) + (size_t)MP * 1024, out, bx, G, (char*)lds);
        PJ_HALF(1);
    }
    GRID_BAR(3);
    PH(4) {
        LOCAL_IDS();
        float lam; { const float a = INF(14)[lane] * INF(15)[lane], b = INF(16)[lane] * INF(17)[lane]; lam = __expf(wave_sum(a)) - __expf(wave_sum(b)) + 0.2f; }
        const int bh = vcu >> 3, s8 = vcu & 7, ab = bh >> 3, ah = bh & 7;
        const float c1 = 8.0f * __builtin_amdgcn_exp2f(-(float)(ah + 1));
#if MK_P4_NS > 0
        {
            const int rs0 = (vcu * MK_P4_NS) >> 8, rs1 = ((vcu + 1) * MK_P4_NS) >> 8;
            const bool streamer = rs1 > rs0;
            const int NC = 256 - MK_P4_NS, rc = vcu - rs0;
            if (streamer) {
                for (int u = rs0; u < 256; u += MK_P4_NS) att::decode_unit(u >> 5, u & 31, INF(2), INF(3), (const int*)args.in[5], WSP(bf16, WS_QB), WSP(float, WS_DPO), WSP(float, WS_DPM), WSP(float, WS_DPL), (char*)lds);
            } else {
                for (int j = 0; j * NC < 512; ++j) {
                    const int idx = j * NC + ((j & 1) ? NC - 1 - rc : rc);
                    if (idx < 512) { const int qb = 15 - (idx >> 5), bh2 = idx & 31; const float c1b = 8.0f * __builtin_amdgcn_exp2f(-(float)((bh2 & 7) + 1));
                        att::MK_ATTN_FN(WSP(bf16, WS_QB), WSP(bf16, WS_KB), WSP(bf16, WS_VB), WSP(bf16, WS_AO), (bh2 >> 3) * SEQ, qb * 128, bh2 & 7, c1b, lam, INF(18), (char*)lds); }
                }
                for (int cu = rc; cu < 512 + 64; cu += NC) att::conv_unit(cu, WSP(bf16, WS_U), INF(4), INF(19), INF(20), INF(21), INF(22), WSP(bf16, WS_AO), (char*)lds);
            }
        }
    }
#else
        for (int pass = 0; pass < 2; ++pass) {
            if ((pass ^ (((vcu & 7) < MK_P4_FS) ? 0 : 1)) == 0) {
                for (int rd_ = 0; rd_ < MK_REP_DEC; ++rd_) att::decode_unit(vcu >> 5, vcu & 31, INF(2), INF(3), (const int*)args.in[5], WSP(bf16, WS_QB), WSP(float, WS_DPO), WSP(float, WS_DPM), WSP(float, WS_DPL), (char*)lds);
            } else {
                for (int k = 0; k < 2 * MK_REP_ATT; ++k)
                    att::MK_ATTN_FN(WSP(bf16, WS_QB), WSP(bf16, WS_KB), WSP(bf16, WS_VB), WSP(bf16, WS_AO), ab * SEQ, ((k & 1) ? 15 - s8 : s8) * 128, ah, c1, lam, INF(18), (char*)lds);
                for (int rc_ = 0; rc_ < MK_REP_CONV; ++rc_) for (int cu = vcu; cu < 512 + 64; cu += G) att::conv_unit(cu, WSP(bf16, WS_U), INF(4), INF(19), INF(20), INF(21), INF(22), WSP(bf16, WS_AO), (char*)lds);
            }
        }
    }
#endif
    GRID_BAR(4);
    PH(5) {
        LOCAL_IDS();
        float lam; { const float a = INF(14)[lane] * INF(15)[lane], b = INF(16)[lane] * INF(17)[lane]; lam = __expf(wave_sum(a)) - __expf(wave_sum(b)) + 0.2f; }
        for (int it = wave * G + vcu; it < DB * NH * DT; it += NGW)
            att::decode_combine(it, WSP(bf16, WS_QB), WSP(bf16, WS_KB), WSP(bf16, WS_VB), WSP(float, WS_DPO), WSP(float, WS_DPM), WSP(float, WS_DPL), WSP(bf16, WS_AO), lam, INF(18), lane);
    }
    GRID_BAR(5);
    PH(6) {
        pg8::Gemm g{WSP(bf16, WS_AO), WSP(bf16, WS_WOT), MP, D, D}; pg8::StaticOrder S; S.init(MP, D, G, bx);
        pg8::EpiResid<2> E{WSP(bf16, WS_H1B), WSP(bf16, WS_H2B), WSP(float, WS_ST3)};
        pg8::gemm_phase<pg8::EpiResid<2>, pg8::StaticOrder, true, MK_SP2>(ldsl, g, S, E);
        sk::resid_phase<2, D>(WSP(bf16, WS_AO) + (size_t)MP * D, WSP(bf16, WS_WOT), WSP(bf16, WS_H1B) + (size_t)MP * D, WSP(bf16, WS_H2B) + (size_t)MP * D, bx, G, (char*)lds);
    }
    GRID_BAR(6);
    PH(7) {
        pg8::Gemm g{WSP(bf16, WS_H2B), WSP(bf16, WS_W3T), MP, 2 * FF, D}; pg8::StaticOrder S; S.init(MP, 2 * FF, G, bx); pg8::EpiSwiGLU E{WSP(bf16, WS_ACT), WSP(float, WS_ST3), FF};
        pg8::gemm_phase<pg8::EpiSwiGLU, pg8::StaticOrder, true, MK_SP2>(ldsl, g, S, E);
        sk::swiglu_phase(WSP(bf16, WS_H2B) + (size_t)MP * D, WSP(bf16, WS_W3T), WSP(bf16, WS_ACT) + (size_t)MP * FF, bx, G, (char*)lds);
    }
    GRID_BAR(7);
    PH(8) {
        pg8::Gemm g{WSP(bf16, WS_ACT), WSP(bf16, WS_W4T), MP, D, FF}; pg8::StaticOrder S; S.init(MP, D, G, bx);
        pg8::EpiResid<1> E{WSP(bf16, WS_H2B), WSP(bf16, WS_H3B), WSP(float, WS_ST4)};
        pg8::gemm_phase<pg8::EpiResid<1>, pg8::StaticOrder, true, MK_SP2>(ldsl, g, S, E);
        sk::resid_phase<1, FF>(WSP(bf16, WS_ACT) + (size_t)MP * FF, WSP(bf16, WS_W4T), WSP(bf16, WS_H2B) + (size_t)MP * D, WSP(bf16, WS_H3B) + (size_t)MP * D, bx, G, (char*)lds);
    }
    GRID_BAR(8);
    PH(9) {
        pg8::Gemm g{WSP(bf16, WS_H3B), WSP(bf16, WS_WPGT), MP, D, D}; pg8::StaticOrder S; S.init(MP, D, G, bx); pg8::EpiPle E{WSP(float, WS_ST4), WSP(bf16, WS_H3B), WSP(bf16, WS_PJ), WSP(bf16, WS_H4)};
        pg8::gemm_phase<pg8::EpiPle, pg8::StaticOrder, true, MK_SP2>(ldsl, g, S, E);
        sk::ple_phase(WSP(bf16, WS_H3B) + (size_t)MP * D, WSP(bf16, WS_WPGT), WSP(bf16, WS_PB) + (size_t)MP * DPLE, WSP(bf16, WS_WPPT), WSP(bf16, WS_H4) + (size_t)MP * D, bx, G, (char*)lds);
    }
    GRID_BAR(9);
    PH(10) {
        LOCAL_IDS();
        const bf16* H4 = WSP(bf16, WS_H4); const float* g_final = INF(31);
        for (int m = gw; m < MREAL; m += NGW) {
            const GAS v4u* hv = (const GAS v4u*)(H4 + (size_t)m * D) + lane;
            v4u raw[4]; float s = 0.f;
#pragma unroll
            for (int j = 0; j < 4; ++j) raw[j] = __builtin_nontemporal_load(hv + 64 * j);
            f32x4 v[8];
#pragma unroll
            for (int j = 0; j < 4; ++j) {
                v[2 * j] = (f32x4){__uint_as_float(raw[j].x << 16), __uint_as_float(raw[j].x & 0xffff0000u), __uint_as_float(raw[j].y << 16), __uint_as_float(raw[j].y & 0xffff0000u)};
                v[2 * j + 1] = (f32x4){__uint_as_float(raw[j].z << 16), __uint_as_float(raw[j].z & 0xffff0000u), __uint_as_float(raw[j].w << 16), __uint_as_float(raw[j].w & 0xffff0000u)};
            }
#pragma unroll
            for (int j = 0; j < 8; ++j) s += (v[j].x * v[j].x + v[j].y * v[j].y) + (v[j].z * v[j].z + v[j].w * v[j].w);
            const float r = __builtin_amdgcn_rsqf(wave_sum(s) * (1.0f / D) + 1e-6f);
            float* orow = m < MP ? out + OY_P + (size_t)m * D : out + OY_S + (size_t)(m - MP) * D;
#pragma unroll
            for (int j = 0; j < 4; ++j) { const int c0 = 8 * lane + 512 * j;
                const f32x4 g0 = *(const GAS f32x4*)(g_final + c0), g1 = *(const GAS f32x4*)(g_final + c0 + 4);
                __builtin_nontemporal_store(v[2 * j] * r * g0, (GAS f32x4*)(orow + c0)); __builtin_nontemporal_store(v[2 * j + 1] * r * g1, (GAS f32x4*)(orow + c0 + 4)); }
        }
    }
#ifdef MK_TAIL_DEC
    { __syncthreads(); if (MK_TAIL_DEC == 2 || (vcu & 1) == 0) att::decode_unit(vcu >> 5, vcu & 31, INF(2), INF(3), (const int*)args.in[5], WSP(bf16, WS_QB), WSP(float, WS_DPO), WSP(float, WS_DPM), WSP(float, WS_DPL), (char*)lds); }
#endif
#ifdef MK_TAIL_MIX
    { __syncthreads(); const int bh = vcu >> 3, s8 = vcu & 7, ab = bh >> 3, ah = bh & 7; const float c1 = 8.0f * __builtin_amdgcn_exp2f(-(float)(ah + 1));
      float lam; { LOCAL_IDS(); const float a = INF(14)[lane] * INF(15)[lane], b = INF(16)[lane] * INF(17)[lane]; lam = __expf(wave_sum(a)) - __expf(wave_sum(b)) + 0.2f; }
      if ((vcu & 1) == 0) att::decode_unit(vcu >> 5, vcu & 31, INF(2), INF(3), (const int*)args.in[5], WSP(bf16, WS_QB), WSP(float, WS_DPO), WSP(float, WS_DPM), WSP(float, WS_DPL), (char*)lds);
      else { for (int k = 0; k < 2; ++k) att::MK_ATTN_FN(WSP(bf16, WS_QB), WSP(bf16, WS_KB), WSP(bf16, WS_VB), WSP(bf16, WS_AO), ab * SEQ, ((k & 1) ? 15 - s8 : s8) * 128, ah, c1, lam, INF(18), (char*)lds); } }
#endif
#ifdef MK_TAIL_ATT
    { __syncthreads(); const int bh = vcu >> 3, s8 = vcu & 7, ab = bh >> 3, ah = bh & 7; const float c1 = 8.0f * __builtin_amdgcn_exp2f(-(float)(ah + 1));
      float lam; { LOCAL_IDS(); const float a = INF(14)[lane] * INF(15)[lane], b = INF(16)[lane] * INF(17)[lane]; lam = __expf(wave_sum(a)) - __expf(wave_sum(b)) + 0.2f; }
      if (MK_TAIL_ATT == 1) { for (int k = 0; k < 2; ++k) att::MK_ATTN_FN(WSP(bf16, WS_QB), WSP(bf16, WS_KB), WSP(bf16, WS_VB), WSP(bf16, WS_AO), ab * SEQ, ((k & 1) ? 15 - s8 : s8) * 128, ah, c1, lam, INF(18), (char*)lds); }
      else { for (int cu = vcu; cu < 512 + 64; cu += G) att::conv_unit(cu, WSP(bf16, WS_U), INF(4), INF(19), INF(20), INF(21), INF(22), WSP(bf16, WS_AO), (char*)lds); } }
#endif
#undef PJ_HALF
#undef IN
#undef PH
#undef GRID_BAR
#undef WSP
#undef INF
}
}

extern "C" void kernel_launch(void* const* d_in, const int* in_sizes, int n_in, void* d_out, int out_size, void* d_ws, size_t ws_size, hipStream_t stream) {
    using namespace mk;
    static int grid = 0;
    if (grid == 0) {
        if (n_in != 32 || out_size != (int)O_END || ws_size < WS_END) { fprintf(stderr, "kernel_launch: unexpected problem shape (n_in %d, out %d, ws %zu); nothing launched\n", n_in, out_size, ws_size); grid = -1; return; }
        int dev = 0, cus = 0, per_cu = 0;
        if (hipGetDevice(&dev) != hipSuccess || hipDeviceGetAttribute(&cus, hipDeviceAttributeMultiprocessorCount, dev) != hipSuccess) { grid = -1; return; }
        if (hipFuncSetAttribute((const void*)hymba_fwd, hipFuncAttributeMaxDynamicSharedMemorySize, LDS_BYTES) != hipSuccess) { fprintf(stderr, "kernel_launch: hipFuncSetAttribute failed\n"); grid = -1; return; }
        if (hipOccupancyMaxActiveBlocksPerMultiprocessor(&per_cu, (const void*)hymba_fwd, NWAVES * 64, LDS_BYTES) != hipSuccess || per_cu < 1)
            fprintf(stderr, "kernel_launch: note: occupancy query reports %d workgroups per CU\n", per_cu);
        (void)hipGetLastError();
        grid = cus;
    }
    if (grid < 0) return;
    if (hipMemsetAsync((char*)d_ws + WS_CTL, 0, CTL_ZERO_BYTES, stream) != hipSuccess) return;
    Args a{};
    for (int i = 0; i < 32; ++i) a.in[i] = d_in[i];
    a.out = (float*)d_out; a.ws = (unsigned char*)d_ws;
#ifndef MK_N_LAUNCHES
#define MK_N_LAUNCHES 1
#endif
    if (MK_N_LAUNCHES == 1) { a.ph_lo = 0; a.ph_hi = N_PHASES; hipLaunchKernelGGL(hymba_fwd, dim3(grid), dim3(NWAVES * 64), LDS_BYTES, stream, a); }
    else { for (int p = 0; p < N_PHASES; ++p) { a.ph_lo = p; a.ph_hi = p + 1; hipLaunchKernelGGL(hymba_fwd, dim3(grid), dim3(NWAVES * 64), LDS_BYTES, stream, a); } }
}
```

```cpp
#include <hip/hip_runtime.h>
#include <cstdio>
#include <cstdint>

namespace mk {
constexpr int D = 2048, FF = 5632, NIN = 5120, DPLE = 256, CW = 1024;
constexpr int MP = 8192, MS = 64, MREAL = MP + MS, MPAD = 8448;
constexpr int SEQ = 2048, NB = 4, NH = 8, DB = 8, DT = 8;
constexpr int NPAGES = 128, PAGE = 128, PAST = NPAGES * PAGE;
constexpr float LOG2E = 1.4426950408889634f;
constexpr size_t OY_P = 0, OY_S = OY_P + (size_t)MP * D, OK_P = OY_S + (size_t)MS * D, OV_P = OK_P + (size_t)MP * 1024, OC_P = OV_P + (size_t)MP * 1024,
                 OK_S = OC_P + (size_t)NB * 30 * CW, OV_S = OK_S + (size_t)MS * 1024, OC_S = OV_S + (size_t)MS * 1024, O_END = OC_S + (size_t)DB * 30 * CW;
static_assert(O_END == 34185216, "output size");
}
namespace pg8 {
#define PG8_LAS __attribute__((address_space(3)))
typedef unsigned short bf16_t;
typedef short bf16x8 __attribute__((ext_vector_type(8)));
typedef float f32x4 __attribute__((ext_vector_type(4)));
typedef unsigned u32x4 __attribute__((ext_vector_type(4)));
constexpr int BM = 256, BK = 64, HALF = 128, HTB = HALF * BK * 2  , STAGE_BYTES = 8 * HTB, NXCD = 8, WGM = 8;

__host__ __device__ __forceinline__ int lds_byte(int r, int c) { const int st = (r >> 4) * 2 + (c >> 5), rr = r & 15, cc = c & 31, ob = rr * 64 + cc * 2; return st * 1024 + (ob ^ (((ob >> 9) & 1) << 5)); }
__host__ __device__ __forceinline__ void stage_rc(int b, int& R, int& C) { const int st = b / 1024, sb = b % 1024, swz = sb ^ (((sb >> 9) & 1) << 5); R = (st >> 1) * 16 + swz / 64; C = (st & 1) * 32 + (swz % 64) / 2; }
__host__ __device__ __forceinline__ int perm32(int rho) { const int n = rho >> 4, i = rho & 15; return 8 * (i >> 2) + 4 * n + (i & 3); }

struct Unit { int pm, pn; };
struct Gemm { const bf16_t* A; const bf16_t* Bt; int M, N, K; };

struct StaticOrder {
    int nM, nN, nwg, G, c;
    __host__ __device__ void init(int M, int N, int G_, int c_) { nM = M / BM; nN = N / BM; nwg = nM * nN; G = G_; c = c_; }
    __host__ __device__ bool next(int i, Unit& u) const {
        const long L = (long)i * G + c; if (L >= nwg) return false;
        int wgid = (int)L; { const int q = nwg / NXCD, r = nwg % NXCD, xcd = wgid % NXCD, off = wgid / NXCD; wgid = (xcd < r ? xcd * (q + 1) : r * (q + 1) + (xcd - r) * q) + off; }
        const int nig = WGM * nN, gid = wgid / nig, fm = gid * WGM, gsz = (nM - fm) < WGM ? (nM - fm) : WGM;
        u.pm = fm + ((wgid % nig) % gsz); u.pn = (wgid % nig) / gsz; return true;
    }
    __host__ __device__ __forceinline__ int pm_of(int i) const {
        const long L = (long)i * G + c; if (L >= nwg) return -1;
        int wgid = (int)L; { const int q = nwg / NXCD, r = nwg % NXCD, xcd = wgid % NXCD, off = wgid / NXCD; wgid = (xcd < r ? xcd * (q + 1) : r * (q + 1) + (xcd - r) * q) + off; }
        const int nig = WGM * nN, gid = wgid / nig, fm = gid * WGM, gsz = (nM - fm) < WGM ? (nM - fm) : WGM;
        return fm + ((wgid % nig) % gsz);
    }
    __device__ __forceinline__ void a_ready(const Unit&) const {}
    __device__ __forceinline__ void done(const Unit&) const {}
};

__device__ __forceinline__ unsigned cvt_pk_bf16(float lo, float hi) { unsigned r; asm volatile("v_cvt_pk_bf16_f32 %0, %1, %2" : "=v"(r) : "v"(lo), "v"(hi)); return r; }
typedef float f32x2 __attribute__((ext_vector_type(2)));
__device__ __forceinline__ float row_rstd(const float* st, int row) {
    const f32x4 a = *(const f32x4*)(st + (size_t)row * 8), b = *(const f32x4*)(st + (size_t)row * 8 + 4);
    const float s = ((a[0] + a[1]) + (a[2] + a[3])) + ((b[0] + b[1]) + (b[2] + b[3]));
    return __builtin_amdgcn_rsqf(s * (1.0f / 2048.0f) + 1e-6f);
}
__device__ __forceinline__ void rows_rstd(const float* st, int row0  , float (&r)[2][4]) {
    f32x4 a[2][4], b[2][4];
#pragma unroll
    for (int ai = 0; ai < 2; ++ai)
#pragma unroll
        for (int m = 0; m < 4; ++m) { const float* p = st + (size_t)(row0 + ai * HALF + m * 16) * 8; a[ai][m] = *(const f32x4*)p; b[ai][m] = *(const f32x4*)(p + 4); }
    __builtin_amdgcn_sched_barrier(0);
#pragma unroll
    for (int ai = 0; ai < 2; ++ai)
#pragma unroll
        for (int m = 0; m < 4; ++m) { const f32x4 x = a[ai][m], y = b[ai][m];
            r[ai][m] = __builtin_amdgcn_rsqf((((x[0] + x[1]) + (x[2] + x[3])) + ((y[0] + y[1]) + (y[2] + y[3]))) * (1.0f / 2048.0f) + 1e-6f); }
}
__device__ __forceinline__ void rows_rstd_lds(const PG8_LAS float* T, int rl0  , float (&r)[2][4]) {
#pragma unroll
    for (int ai = 0; ai < 2; ++ai)
#pragma unroll
        for (int m = 0; m < 4; ++m) r[ai][m] = T[ai * HALF + rl0 + m * 16];
}
__device__ __forceinline__ float sigm(float x) { return __builtin_amdgcn_rcpf(1.0f + __builtin_amdgcn_exp2f(-x * 1.4426950408889634f)); }
__device__ __forceinline__ void st16(void* p, const u32x4 v) { asm volatile("s_nop 1\n\tglobal_store_dwordx4 %0, %1, off sc1" :: "v"(p), "v"(v) : "memory");     }
__device__ __forceinline__ void st16(void* p, const f32x4 v) { asm volatile("s_nop 1\n\tglobal_store_dwordx4 %0, %1, off sc1" :: "v"(p), "v"(v) : "memory");     }
__device__ __forceinline__ void st16p(void* p, const u32x4 v) { *(u32x4*)p = v; }
__device__ __forceinline__ void st16p(void* p, const f32x4 v) { *(f32x4*)p = v; }
#ifndef HO_NT
#define HO_NT 0
#endif
#if HO_NT
#define HO_LD(p) __builtin_nontemporal_load(p)
#else
#define HO_LD(p) (*(p))
#endif
#ifndef WT_MASK
#define WT_MASK 0
#endif
#define ST16(bit, p, v) do { if ((WT_MASK >> (bit)) & 1) st16((p), (v)); else st16p((p), (v)); } while (0)
__device__ __forceinline__ u32x4 pack8bf(const f32x4 a, const f32x4 b) { u32x4 w; w.x = cvt_pk_bf16(a[0], a[1]); w.y = cvt_pk_bf16(a[2], a[3]); w.z = cvt_pk_bf16(b[0], b[1]); w.w = cvt_pk_bf16(b[2], b[3]); return w; }

struct EpiSwiGLU {
    static constexpr bool PERM = true, AFTER_DRAIN = false, ACC_INIT = false;
    bf16_t* O; const float* st; int ldo; int pml;
    __device__ __forceinline__ void operator()(const f32x4 (&acc)[2][2][4][2], const Unit& u, int, int, int, int, PG8_LAS unsigned char* lds, int) const {
        int t_ = threadIdx.x; asm volatile("" : "+v"(t_));
        const int fr = t_ & 15, fq = (t_ >> 4) & 3, wv_ = __builtin_amdgcn_readfirstlane(t_ >> 6), wr = wv_ >> 2, wc = wv_ & 3;
        const int col = u.pn * 128 + wc * 32 + 8 * fq;
        float rr_[2][4]; if (u.pm == pml) rows_rstd_lds((const PG8_LAS float*)(lds + STAGE_BYTES), wr * 64 + fr, rr_); else rows_rstd(st, u.pm * BM + wr * 64 + fr, rr_);
#pragma unroll
        for (int ai = 0; ai < 2; ++ai)
#pragma unroll
            for (int m = 0; m < 4; ++m) {
                const int row = u.pm * BM + ai * HALF + wr * 64 + m * 16 + fr;
                const float r = rr_[ai][m];
                f32x4 v[2];
#pragma unroll
                for (int n = 0; n < 2; ++n)
#pragma unroll
                    for (int j = 0; j < 4; ++j) { const float g = acc[ai][0][m][n][j] * r, up = acc[ai][1][m][n][j] * r; v[n][j] = g * sigm(g) * up; }
                ST16(0, O + (size_t)row * ldo + col, pack8bf(v[0], v[1]));
            }
    }
};
__device__ __forceinline__ void unpack8bf(const u32x4 w, f32x4& a, f32x4& b) {
    a[0] = __uint_as_float(w.x << 16); a[1] = __uint_as_float(w.x & 0xffff0000u); a[2] = __uint_as_float(w.y << 16); a[3] = __uint_as_float(w.y & 0xffff0000u);
    b[0] = __uint_as_float(w.z << 16); b[1] = __uint_as_float(w.z & 0xffff0000u); b[2] = __uint_as_float(w.w << 16); b[3] = __uint_as_float(w.w & 0xffff0000u);
}
template <int ALPHA2  > struct EpiResid {
    static constexpr bool PERM = true, AFTER_DRAIN = false, ACC_INIT = true;
    static constexpr float alpha = 0.5f * ALPHA2, ralpha = 2.0f / ALPHA2;
    const bf16_t* R; bf16_t* Hb; float* st;
    __device__ __forceinline__ void init_load(u32x4 (&rt)[2][4][2], const Unit& u) const {
        int t_ = threadIdx.x; asm volatile("" : "+v"(t_));
        const int fr = t_ & 15, fq = (t_ >> 4) & 3, wv_ = __builtin_amdgcn_readfirstlane(t_ >> 6), wr = wv_ >> 2, wc = wv_ & 3;
#pragma unroll
        for (int ai = 0; ai < 2; ++ai)
#pragma unroll
            for (int m = 0; m < 4; ++m)
#pragma unroll
                for (int bj = 0; bj < 2; ++bj)
                    rt[ai][m][bj] = HO_LD((const u32x4*)(R + (size_t)(u.pm * BM + ai * HALF + wr * 64 + m * 16 + fr) * 2048 + u.pn * BM + bj * HALF + wc * 32 + 8 * fq));
    }
    __device__ __forceinline__ void init_apply(f32x4 (&acc)[2][2][4][2], const u32x4 (&rt)[2][4][2]) const {
#pragma unroll
        for (int ai = 0; ai < 2; ++ai)
#pragma unroll
            for (int m = 0; m < 4; ++m)
#pragma unroll
                for (int bj = 0; bj < 2; ++bj) { f32x4 x0, x1; unpack8bf(rt[ai][m][bj], x0, x1); acc[ai][bj][m][0] = x0 * ralpha; acc[ai][bj][m][1] = x1 * ralpha; }
    }
    __device__ __forceinline__ void operator()(const f32x4 (&acc)[2][2][4][2], const Unit& u, int, int, int, int, PG8_LAS unsigned char* lds, int) const {
        int t_ = threadIdx.x; asm volatile("" : "+v"(t_));
        const int fr = t_ & 15, fq = (t_ >> 4) & 3, wv_ = __builtin_amdgcn_readfirstlane(t_ >> 6), wr = wv_ >> 2, wc = wv_ & 3;
        PG8_LAS float* P = (PG8_LAS float*)(lds + STAGE_BYTES);
#pragma unroll
        for (int ai = 0; ai < 2; ++ai)
#pragma unroll
            for (int m = 0; m < 4; ++m) {
                const int row = u.pm * BM + ai * HALF + wr * 64 + m * 16 + fr;
                float ss = 0.f;
#pragma unroll
                for (int bj = 0; bj < 2; ++bj) {
                    const size_t off = (size_t)row * 2048 + u.pn * BM + bj * HALF + wc * 32 + 8 * fq;
                    const f32x4 v0 = acc[ai][bj][m][0] * alpha, v1 = acc[ai][bj][m][1] * alpha;
                    ST16(1, Hb + off, pack8bf(v0, v1));
                    ss += ((v0[0] * v0[0] + v0[1] * v0[1]) + (v0[2] * v0[2] + v0[3] * v0[3])) + ((v1[0] * v1[0] + v1[1] * v1[1]) + (v1[2] * v1[2] + v1[3] * v1[3]));
                }
                ss += __shfl_xor(ss, 16); ss += __shfl_xor(ss, 32);
                if (fq == 0) P[(ai * HALF + wr * 64 + m * 16 + fr) * 4 + wc] = ss;
            }
        asm volatile("s_waitcnt lgkmcnt(0)" ::: "memory"); __builtin_amdgcn_s_barrier(); asm volatile("" ::: "memory");
        if (t_ < 256) { const f32x4 p = *(const PG8_LAS f32x4*)(P + t_ * 4); st[(size_t)(u.pm * BM + t_) * 8 + u.pn] = (p[0] + p[1]) + (p[2] + p[3]); }
    }
};
struct EpiWin {
    static constexpr bool PERM = true, AFTER_DRAIN = false, ACC_INIT = false;
    const float* st; bf16_t* Q; size_t qkv_stride; bf16_t* U; float* out; int pml;
    __device__ __forceinline__ void operator()(const f32x4 (&acc)[2][2][4][2], const Unit& u, int, int, int, int, PG8_LAS unsigned char* lds, int) const {
        int t_ = threadIdx.x; asm volatile("" : "+v"(t_));
        const int fr = t_ & 15, fq = (t_ >> 4) & 3, wv_ = __builtin_amdgcn_readfirstlane(t_ >> 6), wr = wv_ >> 2, wc = wv_ & 3;
        const int pn = u.pn;
        float rr_[2][4]; if (u.pm == pml) rows_rstd_lds((const PG8_LAS float*)(lds + STAGE_BYTES), wr * 64 + fr, rr_); else rows_rstd(st, u.pm * BM + wr * 64 + fr, rr_);
#pragma unroll
        for (int ai = 0; ai < 2; ++ai)
#pragma unroll
            for (int m = 0; m < 4; ++m) {
                const int row = u.pm * BM + ai * HALF + wr * 64 + m * 16 + fr;
                const float r = rr_[ai][m];
                if (pn < 12) {
                    bf16_t* dst = Q + (size_t)(pn >> 2) * qkv_stride;
                    float* fo = nullptr;
                    if (pn >= 4 && row < mk::MREAL) {
                        const size_t kv = (size_t)((pn >> 2) - 1);
                        fo = row < mk::MP ? out + mk::OK_P + kv * ((size_t)mk::MP * 1024) + (size_t)row * 1024 : out + mk::OK_S + kv * ((size_t)mk::MS * 1024) + (size_t)(row - mk::MP) * 1024;
                    }
#pragma unroll
                    for (int bj = 0; bj < 2; ++bj) {
                        const int col = (pn & 3) * 256 + bj * HALF + wc * 32 + 8 * fq;
                        const f32x4 v0 = acc[ai][bj][m][0] * r, v1 = acc[ai][bj][m][1] * r;
                        ST16(2, dst + (size_t)row * 1024 + col, pack8bf(v0, v1));
                        if (fo) { __builtin_nontemporal_store(v0, (f32x4*)(fo + col)); __builtin_nontemporal_store(v1, (f32x4*)(fo + col + 4)); }
                    }
                } else {
                    const int col = (pn - 12) * 128 + wc * 32 + 8 * fq;
                    f32x4 v[2];
#pragma unroll
                    for (int n = 0; n < 2; ++n)
#pragma unroll
                        for (int j = 0; j < 4; ++j) { const float a = acc[ai][0][m][n][j] * r, g = acc[ai][1][m][n][j] * r; v[n][j] = a * sigm(g); }
                    ST16(2, U + (size_t)row * 1024 + col, pack8bf(v[0], v[1]));
                    float* co = nullptr;
                    if (row < mk::MP) { const int tt = row & 2047; if (tt >= 2018) co = out + mk::OC_P + (size_t)((row >> 11) * 30 + (tt - 2018)) * 1024; }
                    else if (row < mk::MREAL) { const int rs = row - mk::MP; co = out + mk::OC_S + (size_t)((rs >> 3) * 30 + 22 + (rs & 7)) * 1024; }
                    if (co) { __builtin_nontemporal_store(v[0], (f32x4*)(co + col)); __builtin_nontemporal_store(v[1], (f32x4*)(co + col + 4)); }
                }
            }
    }
};
struct EpiPle {
    static constexpr bool PERM = true, AFTER_DRAIN = false, ACC_INIT = false;
    const float* st; const bf16_t* H3; const bf16_t* PJ; bf16_t* H4; int pml;
    __device__ __forceinline__ void operator()(const f32x4 (&acc)[2][2][4][2], const Unit& u, int, int, int, int, PG8_LAS unsigned char* lds, int) const {
        int t_ = threadIdx.x; asm volatile("" : "+v"(t_));
        const int fr = t_ & 15, fq = (t_ >> 4) & 3, wv_ = __builtin_amdgcn_readfirstlane(t_ >> 6), wr = wv_ >> 2, wc = wv_ & 3;
        float rr_[2][4]; if (u.pm == pml) rows_rstd_lds((const PG8_LAS float*)(lds + STAGE_BYTES), wr * 64 + fr, rr_); else rows_rstd(st, u.pm * BM + wr * 64 + fr, rr_);
#pragma unroll
        for (int ai = 0; ai < 2; ++ai) {
            u32x4 ht[4][2], pt[4][2];
#pragma unroll
            for (int m = 0; m < 4; ++m)
#pragma unroll
                for (int bj = 0; bj < 2; ++bj) { const size_t off = (size_t)(u.pm * BM + ai * HALF + wr * 64 + m * 16 + fr) * 2048 + u.pn * BM + bj * HALF + wc * 32 + 8 * fq;
                    ht[m][bj] = HO_LD((const u32x4*)(H3 + off)); pt[m][bj] = HO_LD((const u32x4*)(PJ + off)); }
            __builtin_amdgcn_sched_barrier(0);
#pragma unroll
            for (int m = 0; m < 4; ++m) {
                const int row = u.pm * BM + ai * HALF + wr * 64 + m * 16 + fr;
                const float r = rr_[ai][m];
#pragma unroll
                for (int bj = 0; bj < 2; ++bj) {
                    const size_t off = (size_t)row * 2048 + u.pn * BM + bj * HALF + wc * 32 + 8 * fq;
                    f32x4 h[2], pj[2]; unpack8bf(ht[m][bj], h[0], h[1]); unpack8bf(pt[m][bj], pj[0], pj[1]);
                    f32x4 o[2];
#pragma unroll
                    for (int n = 0; n < 2; ++n)
#pragma unroll
                        for (int j = 0; j < 4; ++j) o[n][j] = h[n][j] + pj[n][j] * sigm(acc[ai][bj][m][n][j] * r);
                    ST16(3, H4 + off, pack8bf(o[0], o[1]));
                }
            }
            __builtin_amdgcn_sched_barrier(0);
        }
    }
};
struct EpiBf16 {
    static constexpr bool PERM = true, AFTER_DRAIN = false, ACC_INIT = false;
    bf16_t* O;
    __device__ __forceinline__ void operator()(const f32x4 (&acc)[2][2][4][2], const Unit& u, int, int, int, int, PG8_LAS unsigned char*, int) const {
        int t_ = threadIdx.x; asm volatile("" : "+v"(t_));
        const int fr = t_ & 15, fq = (t_ >> 4) & 3, wv_ = __builtin_amdgcn_readfirstlane(t_ >> 6), wr = wv_ >> 2, wc = wv_ & 3;
#pragma unroll
        for (int ai = 0; ai < 2; ++ai)
#pragma unroll
            for (int m = 0; m < 4; ++m) {
                const int row = u.pm * BM + ai * HALF + wr * 64 + m * 16 + fr;
#pragma unroll
                for (int bj = 0; bj < 2; ++bj) {
                    const size_t off = (size_t)row * 2048 + u.pn * BM + bj * HALF + wc * 32 + 8 * fq;
                    ST16(4, O + off, pack8bf(acc[ai][bj][m][0], acc[ai][bj][m][1]));
                }
            }
    }
};
#ifndef MK_PF_ON
#define MK_PF_ON 0
#endif
#ifndef MK_LATEWAIT
#define MK_LATEWAIT 1
#endif
#ifndef MK_SERP
#define MK_SERP 1
#endif
#define PG8_PF_DUMMY 147456
template <class Epi, class Sched, bool ALIGN_EPI = false, bool SP2 = false, int PFD = 0>
__device__ __forceinline__ void gemm_phase(PG8_LAS unsigned char* lds, const Gemm g, const Sched& S, const Epi& E) {
    int tid_l = threadIdx.x; asm volatile("" : "+v"(tid_l));
    const int tid = tid_l, wid = __builtin_amdgcn_readfirstlane(tid >> 6), lane = tid & 63, wr = wid >> 2, wc = wid & 3, fr = lane & 15, fq = lane >> 4;
    const int K = g.K, nt = K / BK;
    constexpr bool PFM = PFD > 0; constexpr int NV = PFM ? 4 : 2;
    static_assert(!PFM || SP2, "prefetch mode is written for the SP2 loop");
    unsigned voffA[1], voffB[1];
    { int R, C; stage_rc((PFM ? (tid & 255) : tid) * 16, R, C); const int Rb = Epi::PERM ? ((R & ~31) + perm32(R & 31)) : R;
        voffA[0] = (unsigned)(R * K + C) * 2u; voffB[0] = (unsigned)(Rb * K + C) * 2u; }
    const size_t r32 = (size_t)32 * K * 2;
    const size_t kstep = (size_t)(BK * 2);
    const size_t hstep = (size_t)HALF * K * 2;
    const size_t tstep = 2 * hstep;
    const unsigned ldsw = (unsigned)(PFM ? (wid & 3) : wid) * 1024u; const unsigned pfoff = (unsigned)(((tid & 255) >> 1) * K) * 2u + (unsigned)(tid & 1) * 64u;
    const int aoff = lds_byte(wr * 64 + fr, fq * 8), boff = lds_byte(wc * 32 + fr, fq * 8);
#define PG8_SA(b, h) (((b) * 2 + (h)) * HTB)
#define PG8_SB(b, h) ((4 + (b) * 2 + (h)) * HTB)
#define PG8_STAGE(bufoff, gbase, voff) do { if (!PFM || wr == 0) { _Pragma("unroll") for (int _i = 0; _i < NV; ++_i) \
        __builtin_amdgcn_global_load_lds((const unsigned*)((const char*)(gbase) + (size_t)(PFM ? (_i >> 1) + 2 * (_i & 1) : 2 * _i) * r32 + (voff)[0]), (PG8_LAS unsigned*)(lds + (bufoff) + ldsw + (PFM ? (_i >> 1) * 4096 + (_i & 1) * 8192 : _i * 8192)), 16, 0, 0); } } while (0)
#define PG8_PF(gptr) do { if (PFM && MK_PF_ON && wr == 1) __builtin_amdgcn_global_load_lds((const unsigned*)((const char*)(gptr) + pfoff), (PG8_LAS unsigned*)(lds + PG8_PF_DUMMY), 4, 0, 0); } while (0)
#define PG8_WAIT_VE(n, n2) do { if constexpr (!(PFM && MK_LATEWAIT)) PG8_WAIT_VL(n, n2); } while (0)
#define PG8_WAIT_VT(n2) do { if constexpr (PFM && MK_LATEWAIT) { if (wr == 0) PG8_WAIT_V(n2); } } while (0)
#define PG8_WAIT_VL(n, n2) do { if constexpr (PFM) { if (wr == 0) PG8_WAIT_V(n2); } else PG8_WAIT_V(n); } while (0)
#define PG8_LDA(dst, b, h) do { _Pragma("unroll") for (int m = 0; m < 4; ++m) _Pragma("unroll") for (int k = 0; k < 2; ++k) dst[m][k] = *(const PG8_LAS bf16x8*)(lds + PG8_SA(b, h) + aoff + m * 2048 + k * 1024); } while (0)
#define PG8_LDB(dst, b, h) do { _Pragma("unroll") for (int n = 0; n < 2; ++n) _Pragma("unroll") for (int k = 0; k < 2; ++k) dst[n][k] = *(const PG8_LAS bf16x8*)(lds + PG8_SB(b, h) + boff + n * 2048 + k * 1024); } while (0)
#define PG8_MMA(ai, bj, At, Bt) do { __builtin_amdgcn_s_setprio(1); _Pragma("unroll") for (int m = 0; m < 4; ++m) _Pragma("unroll") for (int n = 0; n < 2; ++n) _Pragma("unroll") for (int k = 0; k < 2; ++k) \
        acc[ai][bj][m][n] = __builtin_amdgcn_mfma_f32_16x16x32_bf16(Bt[n][k], At[m][k], acc[ai][bj][m][n], 0, 0, 0); __builtin_amdgcn_s_setprio(0); } while (0)
#define PG8_WAIT_V(n) asm volatile("s_waitcnt vmcnt(" #n ")" ::: "memory")
#define PG8_WAIT_L(n) asm volatile("s_waitcnt lgkmcnt(" #n ")" ::: "memory")
#define PG8_BAR __builtin_amdgcn_s_barrier()
#define PG8_SCHED __builtin_amdgcn_sched_barrier(0)
    Unit cur, nxt; int ui = 0;
    if (!S.next(0, cur)) return;
    f32x4 acc[2][2][4][2];
#pragma unroll
    for (int a = 0; a < 2; ++a)
#pragma unroll
        for (int b = 0; b < 2; ++b)
#pragma unroll
            for (int m = 0; m < 4; ++m)
#pragma unroll
                for (int n = 0; n < 2; ++n) acc[a][b][m][n] = (f32x4){0.f, 0.f, 0.f, 0.f};
    u32x4 rt0_[2][4][2];
    if constexpr (Epi::ACC_INIT) E.init_load(rt0_, cur);
    bf16x8 At[4][2], B0[2][2], B1[2][2];
    const char* cA = (const char*)g.A + (size_t)cur.pm * tstep; const char* cB = (const char*)g.Bt + (size_t)cur.pn * tstep;
    ptrdiff_t ksc = (ptrdiff_t)kstep, ksn = (ptrdiff_t)kstep;
    S.a_ready(cur);
    if constexpr (SP2) {
        PG8_STAGE(PG8_SB(0, 0), cB, voffB); PG8_STAGE(PG8_SB(0, 1), cB + hstep, voffB); PG8_STAGE(PG8_SA(0, 0), cA, voffA); PG8_STAGE(PG8_SA(0, 1), cA + hstep, voffA);
        if (wr == 1) PG8_BAR;
        PG8_WAIT_VL(2, 4); PG8_BAR;
        PG8_STAGE(PG8_SB(1, 0), cB + ksc, voffB); PG8_STAGE(PG8_SA(1, 0), cA + ksc, voffA); PG8_STAGE(PG8_SB(1, 1), cB + hstep + ksc, voffB);
        if constexpr (PFM) {
            PG8_PF(cA + hstep + kstep);
#pragma unroll
            for (int q = 2; q < 2 + PFD; ++q) { PG8_PF(cB + q * kstep); PG8_PF(cB + hstep + q * kstep); PG8_PF(cA + q * kstep); PG8_PF(cA + hstep + q * kstep); }
        }
        if constexpr (Epi::ACC_INIT) E.init_apply(acc, rt0_);
        PG8_WAIT_VL(6, 12); PG8_BAR;
    } else {
        PG8_STAGE(PG8_SB(0, 0), cB, voffB); PG8_STAGE(PG8_SA(0, 0), cA, voffA); PG8_STAGE(PG8_SB(0, 1), cB + hstep, voffB); PG8_STAGE(PG8_SA(0, 1), cA + hstep, voffA);
        if (wr == 1) PG8_BAR;
        PG8_WAIT_V(4); PG8_BAR;
        PG8_STAGE(PG8_SB(1, 0), cB + ksc, voffB); PG8_STAGE(PG8_SA(1, 0), cA + ksc, voffA); PG8_STAGE(PG8_SB(1, 1), cB + hstep + ksc, voffB);
        if constexpr (Epi::ACC_INIT) E.init_apply(acc, rt0_);
        PG8_WAIT_V(6); PG8_BAR;
    }
    for (;;) {
        const bool has_next = S.next(ui + 1, nxt);
        ksn = (MK_SERP && has_next && nxt.pm == cur.pm) ? -ksc : (has_next ? (ptrdiff_t)kstep : ksc);
        const size_t noff = ksn < 0 ? (size_t)(nt - 1) * kstep : (size_t)0;
        const char* nA = has_next ? (const char*)g.A + (size_t)nxt.pm * tstep + noff : cA; const char* nB = has_next ? (const char*)g.Bt + (size_t)nxt.pn * tstep + noff : cB;
        for (int t = 0; t < nt; t += 2) {
            const bool last = (t == nt - 2);
            const char* a1 = cA + (ptrdiff_t)(t + 1) * ksc;
            const char* a2 = last ? nA : cA + (ptrdiff_t)(t + 2) * ksc; const char* b2 = last ? nB : cB + (ptrdiff_t)(t + 2) * ksc;
            const ptrdiff_t ks3 = last ? ksn : ksc;
            const char* a3 = a2 + ks3; const char* b3 = b2 + ks3;
            if (last && has_next) S.a_ready(nxt);
            const int q1 = t + 1 + PFD, q2 = t + 2 + PFD;
            const char* pa1 = q1 < nt ? cA + (size_t)q1 * kstep : nA + (size_t)(q1 - nt) * kstep;
            const char* pa2 = q2 < nt ? cA + (size_t)q2 * kstep : nA + (size_t)(q2 - nt) * kstep; const char* pb2 = q2 < nt ? cB + (size_t)q2 * kstep : nB + (size_t)(q2 - nt) * kstep;
            if constexpr (SP2) {
            PG8_LDB(B0, 0, 0); PG8_LDB(B1, 0, 1); PG8_SCHED; PG8_LDA(At, 0, 0); PG8_STAGE(PG8_SA(1, 1), a1 + hstep, voffA); PG8_PF(pa1 + hstep);
            PG8_WAIT_VE(8, 16); PG8_WAIT_L(0); PG8_BAR; PG8_MMA(0, 0, At, B0); PG8_MMA(0, 1, At, B1); PG8_WAIT_VT(16); PG8_BAR; PG8_SCHED;
            PG8_LDA(At, 0, 1); PG8_STAGE(PG8_SB(0, 0), b2, voffB); PG8_STAGE(PG8_SB(0, 1), b2 + hstep, voffB); PG8_STAGE(PG8_SA(0, 0), a2, voffA); PG8_PF(pb2); PG8_PF(pb2 + hstep); PG8_PF(pa2);
            PG8_WAIT_VE(8, 16); PG8_WAIT_L(0); PG8_BAR; PG8_MMA(1, 0, At, B0); PG8_MMA(1, 1, At, B1); PG8_WAIT_VT(16); PG8_BAR; PG8_SCHED;
            PG8_LDB(B0, 1, 0); PG8_LDB(B1, 1, 1); PG8_SCHED; PG8_LDA(At, 1, 0); PG8_STAGE(PG8_SA(0, 1), a2 + hstep, voffA); PG8_PF(pa2 + hstep);
            PG8_WAIT_VE(8, 16); PG8_WAIT_L(0); PG8_BAR; PG8_MMA(0, 0, At, B0); PG8_MMA(0, 1, At, B1); PG8_WAIT_VT(16); PG8_BAR; PG8_SCHED;
            PG8_LDA(At, 1, 1); PG8_STAGE(PG8_SB(1, 0), b3, voffB); PG8_STAGE(PG8_SB(1, 1), b3 + hstep, voffB); PG8_STAGE(PG8_SA(1, 0), a3, voffA); PG8_PF(pb2 + kstep); PG8_PF(pb2 + hstep + kstep); PG8_PF(pa2 + kstep);
            PG8_WAIT_VE(8, 16); PG8_WAIT_L(0); PG8_BAR; PG8_MMA(1, 0, At, B0); PG8_MMA(1, 1, At, B1); PG8_WAIT_VT(16); PG8_BAR; PG8_SCHED;
            } else {
            PG8_LDB(B0, 0, 0); PG8_SCHED; PG8_LDA(At, 0, 0); PG8_STAGE(PG8_SA(1, 1), a1 + hstep, voffA);
            PG8_WAIT_L(8); PG8_BAR; PG8_WAIT_L(0); PG8_MMA(0, 0, At, B0); PG8_BAR; PG8_SCHED;
            PG8_LDB(B1, 0, 1); PG8_STAGE(PG8_SB(0, 0), b2, voffB);
            PG8_BAR; PG8_WAIT_L(0); PG8_MMA(0, 1, At, B1); PG8_BAR;
            PG8_LDA(At, 0, 1); PG8_STAGE(PG8_SA(0, 0), a2, voffA);
            PG8_BAR; PG8_WAIT_L(0); PG8_MMA(1, 0, At, B0); PG8_BAR; PG8_SCHED;
            PG8_STAGE(PG8_SB(0, 1), b2 + hstep, voffB);
            PG8_WAIT_V(6); PG8_BAR; PG8_MMA(1, 1, At, B1); PG8_BAR;
            PG8_LDB(B0, 1, 0); PG8_SCHED; PG8_LDA(At, 1, 0); PG8_STAGE(PG8_SA(0, 1), a2 + hstep, voffA);
            PG8_WAIT_L(8); PG8_BAR; PG8_WAIT_L(0); PG8_MMA(0, 0, At, B0); PG8_BAR; PG8_SCHED;
            PG8_LDB(B1, 1, 1); PG8_STAGE(PG8_SB(1, 0), b3, voffB);
            PG8_BAR; PG8_WAIT_L(0); PG8_MMA(0, 1, At, B1); PG8_BAR;
            PG8_LDA(At, 1, 1); PG8_STAGE(PG8_SA(1, 0), a3, voffA);
            PG8_BAR; PG8_WAIT_L(0); PG8_MMA(1, 0, At, B0); PG8_BAR; PG8_SCHED;
            PG8_STAGE(PG8_SB(1, 1), b3 + hstep, voffB);
            PG8_WAIT_V(6); PG8_BAR; PG8_MMA(1, 1, At, B1); PG8_BAR;
            }
        }
        if constexpr (ALIGN_EPI) { if (wr == 0) PG8_BAR; }
        if constexpr (!Epi::AFTER_DRAIN) { E(acc, cur, wr, wc, fr, fq, lds, tid); S.done(cur); }
        if (!has_next) break;
#pragma unroll
        for (int a = 0; a < 2; ++a)
#pragma unroll
            for (int b = 0; b < 2; ++b)
#pragma unroll
                for (int m = 0; m < 4; ++m)
#pragma unroll
                    for (int n = 0; n < 2; ++n) acc[a][b][m][n] = (f32x4){0.f, 0.f, 0.f, 0.f};
        cur = nxt; cA = nA; cB = nB; ksc = ksn; ++ui;
        if constexpr (Epi::ACC_INIT) { u32x4 rtn_[2][4][2]; E.init_load(rtn_, cur); E.init_apply(acc, rtn_); }
        if constexpr (ALIGN_EPI) { if (wr == 1) PG8_BAR; }
    }
    PG8_WAIT_V(0);
    if constexpr (!ALIGN_EPI) { if (wr == 0) PG8_BAR; }
    PG8_BAR;
    if constexpr (Epi::AFTER_DRAIN) { E.fused(acc, cur, wr, wc, fr, fq, lds, wid, lane); S.done(cur); }
#undef PG8_SA
#undef PG8_SB
#undef PG8_STAGE
#undef PG8_PF
#undef PG8_WAIT_VL
#undef PG8_WAIT_VE
#undef PG8_WAIT_VT
#undef PG8_LDA
#undef PG8_LDB
#undef PG8_MMA
#undef PG8_WAIT_V
#undef PG8_WAIT_L
#undef PG8_BAR
#undef PG8_SCHED
}
}
#define GAS __attribute__((address_space(1)))
#define LAS __attribute__((address_space(3)))
typedef unsigned short bf16;
typedef unsigned v4u __attribute__((ext_vector_type(4)));
typedef float f32x4 __attribute__((ext_vector_type(4)));
typedef short bf16x8 __attribute__((ext_vector_type(8)));
typedef GAS unsigned gu32;
typedef GAS unsigned long long gu64;
#define RLX_AGENT __ATOMIC_RELAXED, __HIP_MEMORY_SCOPE_AGENT
#define LDS_WAIT() asm volatile("s_waitcnt lgkmcnt(0)" ::: "memory")
#define VM_WAIT() asm volatile("s_waitcnt vmcnt(0)" ::: "memory")
__device__ __forceinline__ unsigned long long rt() { return __builtin_amdgcn_s_memrealtime(); }
__device__ __forceinline__ unsigned f2bf(float f) { unsigned u = __builtin_bit_cast(unsigned, f); return (u + 0x7fffu + ((u >> 16) & 1u)) >> 16; }
__device__ __forceinline__ unsigned pk2(float lo, float hi) { return f2bf(lo) | (f2bf(hi) << 16); }

#define XB_TMO      128
#define XB_XCNT(j)  (256  + 64 * (j))
#define XB_XSUB(j)  (1280 + 64 * (j))
#define XB_XGEN(j)  (2304 + 64 * (j))
#define XB_TOP      3328
#define XB_TOPGEN   3392
#define XCD_BAR_WORDS 3456
#define XB_SPIN_CAP (1u << 18)

__device__ __forceinline__ unsigned xb_ld(unsigned* p)              { return __hip_atomic_load(p, __ATOMIC_RELAXED, __HIP_MEMORY_SCOPE_AGENT); }
__device__ __forceinline__ unsigned xb_add(unsigned* p, unsigned v) { return __hip_atomic_fetch_add(p, v, __ATOMIC_RELAXED, __HIP_MEMORY_SCOPE_AGENT); }
__device__ __forceinline__ unsigned xb_xcc_id() { return (unsigned)__builtin_amdgcn_s_getreg((3 << 11) | 20) & 0xFu; }
#define XB_SPIN(cond, bar) do { unsigned _sp = 0; while (cond) { __builtin_amdgcn_s_sleep(1); \
    if ((++_sp & 255u) == 0u) { if (xb_ld(&(bar)[XB_TMO])) break; if (_sp > XB_SPIN_CAP) { atomicAdd(&(bar)[XB_TMO], 1u); break; } } } } while (0)

struct XcdBarrier {
    unsigned* bar; unsigned x;
    volatile LAS unsigned* st;
};

__device__ __forceinline__ XcdBarrier xcd_barrier_post(unsigned* bar, volatile LAS unsigned* st) {
    XcdBarrier b; b.bar = bar; b.x = xb_xcc_id(); b.st = st;
    if (threadIdx.x == 0) (void)xb_add(&bar[XB_XCNT(b.x)], 1u);
    return b;
}
__device__ __forceinline__ void xcd_barrier_complete(unsigned* bar, unsigned x, unsigned& nloc, unsigned& nx) {
    const unsigned G = gridDim.x * gridDim.y * gridDim.z;
    unsigned sum, cnt, mine, sp = 0u;
    for (;;) {
        sum = 0u; cnt = 0u; mine = 0u;
#pragma unroll
        for (unsigned j = 0; j < 16; ++j) { const unsigned c = xb_ld(&bar[XB_XCNT(j)]); sum += c; cnt += (c > 0u) ? 1u : 0u; mine = (j == x) ? c : mine; }
        if (sum == G) break;
        __builtin_amdgcn_s_sleep(1);
        if ((++sp & 255u) == 0u) { if (xb_ld(&bar[XB_TMO])) break; if (sp > XB_SPIN_CAP) { atomicAdd(&bar[XB_TMO], 1u); break; } }
    }
    nloc = mine > 0u ? mine : 1u; nx = cnt > 0u ? cnt : 1u;
}

__device__ __forceinline__ void xcd_barrier(const XcdBarrier& b) {
    asm volatile("s_waitcnt vmcnt(0)" ::: "memory");
    __syncthreads();
    if (threadIdx.x == 0) {
        unsigned* bar = b.bar;
        __builtin_amdgcn_s_waitcnt(0);
        unsigned nloc = b.st[0], nx = b.st[1];
        if (nloc == 0u) { xcd_barrier_complete(bar, b.x, nloc, nx); b.st[0] = nloc; b.st[1] = nx; }
        const unsigned old = xb_add(&bar[XB_XSUB(b.x)], 1u);
        const unsigned gen = old / nloc;
        if (old + 1u == (gen + 1u) * nloc) {
            __builtin_amdgcn_fence(__ATOMIC_RELEASE, "agent");
            asm volatile("s_waitcnt vmcnt(0)" ::: "memory");
            const unsigned og = xb_add(&bar[XB_TOP], 1u);
            const unsigned tg = og / nx;
            if (og + 1u == (tg + 1u) * nx) xb_add(&bar[XB_TOPGEN], 1u);
            else XB_SPIN(xb_ld(&bar[XB_TOPGEN]) == tg, bar);
            __builtin_amdgcn_fence(__ATOMIC_ACQUIRE, "agent");
            xb_add(&bar[XB_XGEN(b.x)], 1u);
            asm volatile("s_waitcnt vmcnt(0)" ::: "memory");
        } else {
            XB_SPIN(xb_ld(&bar[XB_XGEN(b.x)]) == gen, bar);
            __builtin_amdgcn_fence(__ATOMIC_ACQUIRE, "agent");
            asm volatile("s_waitcnt vmcnt(0)" ::: "memory");
        }
    }
    __syncthreads();
}
namespace att {
typedef short bf16x8 __attribute__((ext_vector_type(8)));
typedef short s16x4 __attribute__((ext_vector_type(4)));
typedef float f32x16 __attribute__((ext_vector_type(16)));
typedef float f32x4 __attribute__((ext_vector_type(4)));
typedef unsigned u32x4 __attribute__((ext_vector_type(4)));
typedef unsigned short bf16_t;
constexpr int KVBLK = 64, QBLK = 32;
constexpr int SHM_V = KVBLK * 128 * 2, SHM_K = KVBLK * 128 * 2;
constexpr float SCALE = 0.125f, THR = 8.f;
#define KSWZ(row, colB) ((row) * 256 + ((colB) ^ (((row) & 7) << 4)))
#define SBAR() __builtin_amdgcn_sched_barrier(0)
__device__ __forceinline__ int v_st(int k, int c) { const int kk = (k & ~0xC) | ((k & 4) << 1) | ((k & 8) >> 1); return ((kk >> 3) * 4 + (c >> 5)) * 512 + ((kk & 7) * 32 + (c & 31)) * 2; }
__device__ __forceinline__ int v_rd_base(int lane) { return ((lane & 3) << 3) | (((lane >> 2) & 3) << 6) | (((lane >> 4) & 1) << 5) | (((lane >> 5) & 1) << 8); }
constexpr int v_rd_off(int d0, int ks, int half) { return d0 * 512 + ks * 4096 + half * 2048; }
__device__ __forceinline__ int crow(int r, int hi) { return (r & 3) + 8 * (r >> 2) + 4 * hi; }
__device__ __forceinline__ unsigned cvtpk(float lo, float hi) { unsigned r; asm volatile("v_cvt_pk_bf16_f32 %0, %1, %2" : "=v"(r) : "v"(lo), "v"(hi)); return r; }
__device__ __forceinline__ float bf2f(bf16_t x) { return __uint_as_float((unsigned)x << 16); }
__device__ __forceinline__ void mask_tile(f32x16& p0, f32x16& p1, int dq) {
    const float NEG = -__builtin_inff();
#pragma unroll
    for (int r = 0; r < 16; ++r) {
        const int c = (r & 3) + 8 * (r >> 2);
        if (dq - c < 0) p0[r] = NEG;
        if (dq - c - 32 < 0) p1[r] = NEG;
    }
}
__device__ __forceinline__ void partialSM(f32x16& p0, f32x16& p1, float& m_reg, float& mn, float& alpha) {
    float pmax = p0[0];
#pragma unroll
    for (int r = 1; r < 16; ++r) pmax = fmaxf(pmax, p0[r]);
#pragma unroll
    for (int r = 0; r < 16; ++r) pmax = fmaxf(pmax, p1[r]);
    { auto rr = __builtin_amdgcn_permlane32_swap(__float_as_uint(pmax), __float_as_uint(pmax), false, false);
      pmax = fmaxf(__uint_as_float(rr[0]), __uint_as_float(rr[1])); }
    constexpr float C2 = 1.4426950408889634f * SCALE;
    if (__builtin_expect(__all((pmax - m_reg) * SCALE <= THR), 1)) { mn = m_reg; alpha = 1.f; }
    else { mn = fmaxf(m_reg, pmax); alpha = __builtin_amdgcn_exp2f((m_reg - mn) * C2); m_reg = mn; }
    const float mnL = -mn * C2;
    p0 = p0 * C2 + mnL; p1 = p1 * C2 + mnL;
#pragma unroll
    for (int r = 0; r < 16; ++r) p0[r] = __builtin_amdgcn_exp2f(p0[r]);
}
__device__ __forceinline__ void finishSM(f32x16& p0, f32x16& p1, float alpha, float& l_reg, bf16x8& pa0, bf16x8& pa1, bf16x8& pa2, bf16x8& pa3) {
#pragma unroll
    for (int r = 0; r < 16; ++r) p1[r] = __builtin_amdgcn_exp2f(p1[r]);
    typedef float f32x2_ __attribute__((ext_vector_type(2)));
    f32x2_ ps2 = {p0[0], p0[1]};
#pragma unroll
    for (int r = 2; r < 16; r += 2) { const f32x2_ v_ = {p0[r], p0[r + 1]}; ps2 += v_; }
#pragma unroll
    for (int r = 0; r < 16; r += 2) { const f32x2_ v_ = {p1[r], p1[r + 1]}; ps2 += v_; }
    float ps = ps2[0] + ps2[1];
    { auto rr = __builtin_amdgcn_permlane32_swap(__float_as_uint(ps), __float_as_uint(ps), false, false);
      ps = __uint_as_float(rr[0]) + __uint_as_float(rr[1]); }
    l_reg = l_reg * alpha + ps;
#define PK4(P, B_, OUT) do { unsigned a0 = cvtpk(P[B_+0], P[B_+1]), a1 = cvtpk(P[B_+2], P[B_+3]);                          \
        unsigned b0 = cvtpk(P[B_+4], P[B_+5]), b1 = cvtpk(P[B_+6], P[B_+7]);                                             \
        auto r0 = __builtin_amdgcn_permlane32_swap(a0, b0, false, false); auto r1 = __builtin_amdgcn_permlane32_swap(a1, b1, false, false); \
        u32x4 w = {r0[0], r1[0], r0[1], r1[1]}; OUT = *reinterpret_cast<bf16x8*>(&w); } while (0)
    PK4(p0, 0, pa0); PK4(p0, 8, pa1); PK4(p1, 0, pa2); PK4(p1, 8, pa3);
#undef PK4
}
template <int KB>
__device__ __forceinline__ void qkt(f32x16& p0, f32x16& p1, const char* K_lds, int r32, int hi, int moff, const bf16x8* qr, const f32x16& cb, float t0, float t1) {
    p0 = cb + t0; p1 = cb + t1;
    const char* kb[4];
#pragma unroll
    for (int dd = 0; dd < 4; ++dd) kb[dd] = K_lds + KB * SHM_K + KSWZ(r32, (dd * 16 + hi * 8) * 2) + moff;
#pragma unroll
    for (int d0 = 0; d0 < 4; ++d0) {
        bf16x8 b0 = *reinterpret_cast<const bf16x8*>(kb[d0]);
        bf16x8 b1 = *reinterpret_cast<const bf16x8*>(kb[d0] + 32 * 256);
        p0 = __builtin_amdgcn_mfma_f32_32x32x16_bf16(b0, qr[d0], p0, 0, 0, 0);
        p1 = __builtin_amdgcn_mfma_f32_32x32x16_bf16(b1, qr[d0], p1, 0, 0, 0); }
}
template <int VB>
__device__ __forceinline__ void pv_tile(f32x16* o, int vb0, bf16x8 pa0, bf16x8 pa1, bf16x8 pa2, bf16x8 pa3) {
#define TRRD(dst, off) asm volatile("ds_read_b64_tr_b16 %0, %1 offset:%2" : "=&v"(dst) : "v"(vb0), "i"(off) : "memory")
#define PV_D0(d0) do { s16x4 l0, l1, l2, l3, h0, h1, h2, h3; constexpr int b_ = VB * SHM_V + v_rd_off(d0, 0, 0); \
        TRRD(l0, b_); TRRD(h0, b_ + 2048); TRRD(l1, b_ + 4096); TRRD(h1, b_ + 6144); TRRD(l2, b_ + 8192); TRRD(h2, b_ + 10240); TRRD(l3, b_ + 12288); TRRD(h3, b_ + 14336); \
        asm volatile("s_waitcnt lgkmcnt(0)" ::: "memory"); SBAR();   \
        o[d0] = __builtin_amdgcn_mfma_f32_32x32x16_bf16(pa0, (bf16x8){l0[0], l0[1], l0[2], l0[3], h0[0], h0[1], h0[2], h0[3]}, o[d0], 0, 0, 0);   \
        o[d0] = __builtin_amdgcn_mfma_f32_32x32x16_bf16(pa1, (bf16x8){l1[0], l1[1], l1[2], l1[3], h1[0], h1[1], h1[2], h1[3]}, o[d0], 0, 0, 0);   \
        o[d0] = __builtin_amdgcn_mfma_f32_32x32x16_bf16(pa2, (bf16x8){l2[0], l2[1], l2[2], l2[3], h2[0], h2[1], h2[2], h2[3]}, o[d0], 0, 0, 0);   \
        o[d0] = __builtin_amdgcn_mfma_f32_32x32x16_bf16(pa3, (bf16x8){l3[0], l3[1], l3[2], l3[3], h3[0], h3[1], h3[2], h3[3]}, o[d0], 0, 0, 0); } while (0)
    PV_D0(0); PV_D0(1); PV_D0(2); PV_D0(3);
#undef PV_D0
#undef TRRD
}
typedef short v4i16_t __attribute__((ext_vector_type(4)));
__device__ __forceinline__ void pv_tile2(f32x16* o, int vbase, bf16x8 pa0, bf16x8 pa1, bf16x8 pa2, bf16x8 pa3) {
    typedef __attribute__((address_space(3))) v4i16_t* ldsv4;
#define TRV(off) __builtin_amdgcn_ds_read_tr16_b64_v4i16((ldsv4)(vbase + (off)))
#define CAT(lo, hi) __builtin_shufflevector(lo, hi, 0, 1, 2, 3, 4, 5, 6, 7)
#pragma unroll
    for (int d0 = 0; d0 < 4; ++d0) {
        const int b_ = v_rd_off(d0, 0, 0);
        const v4i16_t l0 = TRV(b_), h0 = TRV(b_ + 2048), l1 = TRV(b_ + 4096), h1 = TRV(b_ + 6144), l2 = TRV(b_ + 8192), h2 = TRV(b_ + 10240), l3 = TRV(b_ + 12288), h3 = TRV(b_ + 14336);
        o[d0] = __builtin_amdgcn_mfma_f32_32x32x16_bf16(pa0, CAT(l0, h0), o[d0], 0, 0, 0);
        o[d0] = __builtin_amdgcn_mfma_f32_32x32x16_bf16(pa1, CAT(l1, h1), o[d0], 0, 0, 0);
        o[d0] = __builtin_amdgcn_mfma_f32_32x32x16_bf16(pa2, CAT(l2, h2), o[d0], 0, 0, 0);
        o[d0] = __builtin_amdgcn_mfma_f32_32x32x16_bf16(pa3, CAT(l3, h3), o[d0], 0, 0, 0);
    }
#undef TRV
#undef CAT
}
#define VMW() asm volatile("s_waitcnt vmcnt(0)" ::: "memory")
__device__ __forceinline__ void attn_block(const bf16_t* QB, const bf16_t* KBp, const bf16_t* VBp, bf16_t* AO, int seq0, int P0, int h, float c1, float lam, const float* gsub, char* lds) {
    int tid_l = threadIdx.x; asm volatile("" : "+v"(tid_l));
    const int tid = tid_l, wid = __builtin_amdgcn_readfirstlane(tid >> 6), lane = tid & 63, r32 = lane & 31, hi = lane >> 5;
    const int mp = wid & 1, rg = wid >> 1;
    const int NT = (P0 + 128) / KVBLK;
    const int qlo = P0 + rg * QBLK, qm = qlo + r32 - 4 * hi;
    char* V_lds = lds; char* K_lds = lds + 2 * SHM_V;
    float* ws = (float*)(lds + 2 * SHM_V + 2 * SHM_K) + wid * 64; float* li_l = ws, * al_l = ws + 32;
    const int sr = tid >> 4, sc = (tid & 15) * 8, vst0 = v_st(sr, sc), vst1 = v_st(32 + sr, sc), kws = KSWZ(sr, sc * 2);
    const int vb0 = (int)(uintptr_t)V_lds + v_rd_base(lane);
    const bf16_t* Kh = KBp + (size_t)seq0 * 1024 + h * 128 + sc; const bf16_t* Vh = VBp + (size_t)seq0 * 1024 + h * 128 + sc;
    bf16x8 qr[4];
#pragma unroll
    for (int d0 = 0; d0 < 4; ++d0) qr[d0] = *reinterpret_cast<const bf16x8*>(QB + (size_t)(seq0 + qlo + r32) * 1024 + h * 128 + mp * 64 + d0 * 16 + hi * 8);
    f32x16 cb;
#pragma unroll
    for (int r = 0; r < 16; ++r) cb[r] = c1 * (float)crow(r, hi);
    const int moff = mp * 128;
    bf16x8 sv0[2], sv1[2], sk0[2], sk1[2];
#define SLOAD(k0, R) do { sv0[R] = *reinterpret_cast<const bf16x8*>(Vh + (size_t)((k0) + sr) * 1024); sv1[R] = *reinterpret_cast<const bf16x8*>(Vh + (size_t)((k0) + 32 + sr) * 1024); \
                          sk0[R] = *reinterpret_cast<const bf16x8*>(Kh + (size_t)((k0) + sr) * 1024); sk1[R] = *reinterpret_cast<const bf16x8*>(Kh + (size_t)((k0) + 32 + sr) * 1024); } while (0)
#define SWRITE(bf, R) do { *(bf16x8*)(V_lds + (bf) * SHM_V + vst0) = sv0[R]; *(bf16x8*)(V_lds + (bf) * SHM_V + vst1) = sv1[R]; \
                           *(bf16x8*)(K_lds + (bf) * SHM_K + kws) = sk0[R]; *(bf16x8*)(K_lds + (bf) * SHM_K + kws + 32 * 256) = sk1[R]; } while (0)
#define VMW4() asm volatile("s_waitcnt vmcnt(4)" ::: "memory")
#define TB0(t) (c1 * (float)((t) * KVBLK - P0))
#define MASKT(P0_, P1_, t) do { const int kb_ = (t) * KVBLK; if (kb_ + KVBLK - 1 > qlo) mask_tile(P0_, P1_, qm - kb_); } while (0)
#define RESC(a) do { if (__any((a) < 1.f)) { if (hi == 0) al_l[r32] = (a); asm volatile("s_waitcnt lgkmcnt(0)" ::: "memory");              \
                     _Pragma("unroll") for (int d_ = 0; d_ < 4; ++d_) _Pragma("unroll") for (int r = 0; r < 16; ++r) o[d_][r] *= al_l[crow(r, hi)]; } } while (0)
    float m_reg = -1e30f, l_reg = 0; f32x16 o[4] = {};
    f32x16 pA0, pA1, pB0, pB1; float mnA, mnB, alA, alB; bf16x8 pa0, pa1, pa2, pa3;
    SLOAD(0, 0); VMW(); SWRITE(0, 0); SBAR();
    SLOAD(KVBLK, 1); if (NT > 2) SLOAD(2 * KVBLK, 0);
    __syncthreads();
    { const float t0 = TB0(0); qkt<0>(pA0, pA1, K_lds, r32, hi, moff, qr, cb, t0, t0 + 32.f * c1); }
    MASKT(pA0, pA1, 0); partialSM(pA0, pA1, m_reg, mnA, alA);
    if (NT > 2) { VMW4(); } else { VMW(); }
    SWRITE(1, 1);
    __syncthreads();
#define HALF_STEP(PX0, PX1, mnX, alX, PY0, PY1, alY, t, KB, VB, SB, RL, RW) do {                                              \
        SBAR(); if ((t) + 2 < NT) { SLOAD(((t) + 2) * KVBLK, RL); SBAR(); }                                                    \
        { const float t0 = TB0(t); qkt<KB>(PX0, PX1, K_lds, r32, hi, moff, qr, cb, t0, t0 + 32.f * c1); }                      \
        finishSM(PY0, PY1, alY, l_reg, pa0, pa1, pa2, pa3); SBAR();                                                           \
        pv_tile<VB>(o, vb0, pa0, pa1, pa2, pa3); MASKT(PX0, PX1, (t)); partialSM(PX0, PX1, m_reg, mnX, alX);                  \
        __syncthreads();                                                                                                      \
        if ((t) + 1 < NT) { if ((t) + 2 < NT) { VMW4(); } else { VMW(); } SWRITE(SB, RW); }                                   \
        RESC(alX); __syncthreads(); } while (0)
    for (int t = 1; t + 1 < NT; t += 2) {
        HALF_STEP(pB0, pB1, mnB, alB, pA0, pA1, alA, t, 1, 0, 0, 1, 0);
        HALF_STEP(pA0, pA1, mnA, alA, pB0, pB1, alB, t + 1, 0, 1, 1, 0, 1);
    }
    SBAR(); { const float t0 = TB0(NT - 1); qkt<1>(pB0, pB1, K_lds, r32, hi, moff, qr, cb, t0, t0 + 32.f * c1); } SBAR();
    finishSM(pA0, pA1, alA, l_reg, pa0, pa1, pa2, pa3); SBAR();
    pv_tile<0>(o, vb0, pa0, pa1, pa2, pa3);
    MASKT(pB0, pB1, NT - 1); partialSM(pB0, pB1, m_reg, mnB, alB); __syncthreads(); RESC(alB);
    finishSM(pB0, pB1, alB, l_reg, pa0, pa1, pa2, pa3); SBAR(); pv_tile<1>(o, vb0, pa0, pa1, pa2, pa3);
    if (hi == 0) li_l[r32] = l_reg; asm volatile("s_waitcnt lgkmcnt(0)" ::: "memory");
#pragma unroll
    for (int r = 0; r < 16; ++r) { const float rl = __builtin_amdgcn_rcpf(li_l[crow(r, hi)]);
#pragma unroll
        for (int d0 = 0; d0 < 4; ++d0) o[d0][r] *= rl; }
    __syncthreads();
    float* X = (float*)lds + rg * 4096;
    if (mp == 1) {
#pragma unroll
        for (int d0 = 0; d0 < 4; ++d0)
#pragma unroll
            for (int r = 0; r < 16; ++r) X[(d0 * 16 + r) * 64 + lane] = o[d0][r];
    }
    __syncthreads();
    if (mp == 0) {
        float gs[4];
#pragma unroll
        for (int d0 = 0; d0 < 4; ++d0) gs[d0] = gsub[d0 * 32 + r32] * 0.8f;
#pragma unroll
        for (int r = 0; r < 16; ++r) {
            float y[4]; float ss = 0.f;
#pragma unroll
            for (int d0 = 0; d0 < 4; ++d0) { y[d0] = o[d0][r] - lam * X[(d0 * 16 + r) * 64 + lane]; ss += y[d0] * y[d0]; }
            ss += __shfl_xor(ss, 1); ss += __shfl_xor(ss, 2); ss += __shfl_xor(ss, 4); ss += __shfl_xor(ss, 8); ss += __shfl_xor(ss, 16);
            const float sc_ = __builtin_amdgcn_rsqf(ss * (1.0f / 128.0f) + 1e-6f);
            bf16_t* orow = AO + (size_t)(seq0 + qlo + crow(r, hi)) * 2048 + h * 128;
#pragma unroll
            for (int d0 = 0; d0 < 4; ++d0) { const float v = y[d0] * sc_ * gs[d0]; const float vn = __shfl_xor(v, 1);
                if ((r32 & 1) == 0) *(unsigned*)(orow + d0 * 32 + r32) = cvtpk(v, vn); }
        }
    }
    __syncthreads();
#undef SLOAD
#undef SWRITE
#undef VMW4
#undef TB0
#undef MASKT
#undef RESC
#undef HALF_STEP
}


#ifndef MK_ATT_LOCKSTEP
#define MK_ATT_LOCKSTEP 1
#endif
#ifndef MK_PV
#define MK_PV pv_tile2
#endif
__device__ __forceinline__ void attn_block_dma(const bf16_t* QB, const bf16_t* KBp, const bf16_t* VBp, bf16_t* AO, int seq0, int P0, int h, float c1, float lam, const float* gsub, char* lds) {
    typedef __attribute__((address_space(3))) unsigned char* lds3_t;
    int tid_l = threadIdx.x; asm volatile("" : "+v"(tid_l));
    const int tid = tid_l, wid = __builtin_amdgcn_readfirstlane(tid >> 6), lane = tid & 63, r32 = lane & 31, hi = lane >> 5;
    const int mp = wid & 1, rg = wid >> 1;
    const int NT = (P0 + 128) / KVBLK;
    const int qlo = P0 + rg * QBLK, qm = qlo + r32 - 4 * hi;
    constexpr int SLOT = SHM_V + SHM_K;
    float* ws = (float*)(lds + 4 * SLOT) + wid * 64; float* li_l = ws, * al_l = ws + 32;
    const lds3_t l3 = (lds3_t)lds;
    const int vb0 = (int)(uintptr_t)lds + v_rd_base(lane);
    const bf16_t* Kbase = KBp + (size_t)seq0 * 1024 + h * 128; const bf16_t* Vbase = VBp + (size_t)seq0 * 1024 + h * 128;
    bf16x8 qr[4];
#pragma unroll
    for (int d0 = 0; d0 < 4; ++d0) qr[d0] = *reinterpret_cast<const bf16x8*>(QB + (size_t)(seq0 + qlo + r32) * 1024 + h * 128 + mp * 64 + d0 * 16 + hi * 8);
    f32x16 cb;
#pragma unroll
    for (int r = 0; r < 16; ++r) cb[r] = c1 * (float)crow(r, hi);
    const int moff = mp * 128;
    int koff[2], voff[2];
#pragma unroll
    for (int i = 0; i < 2; ++i) { const int j = 2 * wid + i;
        { const int row = 4 * j + (lane >> 4), c = (lane & 15) ^ (row & 7); koff[i] = row * 1024 + c * 8; }
        { const int p = 64 * j + lane, sub = p >> 5, q = p & 31, kk = (sub >> 2) * 8 + (q >> 2), c8 = (sub & 3) * 4 + (q & 3), k = (kk & ~0xC) | ((kk & 4) << 1) | ((kk & 8) >> 1); voff[i] = k * 1024 + c8 * 8; } }
#define DMA_TILE(t) do { const int tt_ = (t) < NT ? (t) : NT - 1; const int sl_ = ((t) & 3) * SLOT + 2 * wid * 1024; \
        const bf16_t* kb_ = Kbase + (size_t)tt_ * (KVBLK * 1024); const bf16_t* vb_ = Vbase + (size_t)tt_ * (KVBLK * 1024); \
        _Pragma("unroll") for (int i = 0; i < 2; ++i) __builtin_amdgcn_global_load_lds((const unsigned*)(vb_ + voff[i]), (__attribute__((address_space(3))) unsigned*)(l3 + __builtin_amdgcn_readfirstlane(sl_ + i * 1024)), 16, 0, 0); \
        _Pragma("unroll") for (int i = 0; i < 2; ++i) __builtin_amdgcn_global_load_lds((const unsigned*)(kb_ + koff[i]), (__attribute__((address_space(3))) unsigned*)(l3 + __builtin_amdgcn_readfirstlane(sl_ + SHM_V + i * 1024)), 16, 0, 0); } while (0)
#define WAITV(N) asm volatile("s_waitcnt vmcnt(" #N ")" ::: "memory")
#define RBAR() do { asm volatile("s_waitcnt lgkmcnt(0)" ::: "memory"); __builtin_amdgcn_s_barrier(); asm volatile("" ::: "memory"); } while (0)
#define KSLOT(t) (lds + ((t) & 3) * SLOT + SHM_V)
#define VSLOT(t) (vb0 + ((t) & 3) * SLOT)
#define TB0(t) (c1 * (float)((t) * KVBLK - P0))
#define MASKT(P0_, P1_, t) do { const int kb_ = (t) * KVBLK; if (kb_ + KVBLK - 1 > qlo) mask_tile(P0_, P1_, qm - kb_); } while (0)
#define RESC(a) do { if (__any((a) < 1.f)) { if (hi == 0) al_l[r32] = (a); asm volatile("s_waitcnt lgkmcnt(0)" ::: "memory");              \
                     _Pragma("unroll") for (int d_ = 0; d_ < 4; ++d_) _Pragma("unroll") for (int r = 0; r < 16; ++r) o[d_][r] *= al_l[crow(r, hi)]; } } while (0)
    float m_reg = -1e30f, l_reg = 0; f32x16 o[4] = {};
    f32x16 pA0, pA1, pB0, pB1; float mnA, mnB, alA, alB; bf16x8 pa0, pa1, pa2, pa3;
    DMA_TILE(0); DMA_TILE(1); DMA_TILE(2); DMA_TILE(3);
    WAITV(12); RBAR();
    { const float t0 = TB0(0); qkt<0>(pA0, pA1, KSLOT(0), r32, hi, moff, qr, cb, t0, t0 + 32.f * c1); }
    MASKT(pA0, pA1, 0); partialSM(pA0, pA1, m_reg, mnA, alA);
    WAITV(8); RBAR();
#define HALF_STEP_A(PX0, PX1, mnX, alX, PY0, PY1, alY, t) do {                                                                \
        SBAR(); { const float t0_ = TB0(t); qkt<0>(PX0, PX1, KSLOT(t), r32, hi, moff, qr, cb, t0_, t0_ + 32.f * c1); }         \
        finishSM(PY0, PY1, alY, l_reg, pa0, pa1, pa2, pa3); SBAR();                                                           \
        MK_PV(o, VSLOT((t) - 1), pa0, pa1, pa2, pa3); MASKT(PX0, PX1, (t)); partialSM(PX0, PX1, m_reg, mnX, alX);              \
        WAITV(4); RESC(alX); RBAR();                                                                                          \
        DMA_TILE((t) + 3); } while (0)
#define HALF_STEP_B(PX0, PX1, mnX, alX, PY0, PY1, alY, t) do {                                                                \
        SBAR(); finishSM(PY0, PY1, alY, l_reg, pa0, pa1, pa2, pa3); SBAR();                                                   \
        { const float t0_ = TB0(t); qkt<0>(PX0, PX1, KSLOT(t), r32, hi, moff, qr, cb, t0_, t0_ + 32.f * c1); } SBAR();         \
        MASKT(PX0, PX1, (t)); partialSM(PX0, PX1, m_reg, mnX, alX); SBAR();                                                   \
        MK_PV(o, VSLOT((t) - 1), pa0, pa1, pa2, pa3);                                                                         \
        WAITV(4); RESC(alX); RBAR();                                                                                          \
        DMA_TILE((t) + 3); } while (0)
    if (MK_ATT_LOCKSTEP || wid < 4) {
        for (int t = 1; t + 1 < NT; t += 2) {
            HALF_STEP_A(pB0, pB1, mnB, alB, pA0, pA1, alA, t);
            HALF_STEP_A(pA0, pA1, mnA, alA, pB0, pB1, alB, t + 1);
        }
    } else {
        for (int t = 1; t + 1 < NT; t += 2) {
            HALF_STEP_B(pB0, pB1, mnB, alB, pA0, pA1, alA, t);
            HALF_STEP_B(pA0, pA1, mnA, alA, pB0, pB1, alB, t + 1);
        }
    }
    SBAR(); { const float t0 = TB0(NT - 1); qkt<0>(pB0, pB1, KSLOT(NT - 1), r32, hi, moff, qr, cb, t0, t0 + 32.f * c1); } SBAR();
    finishSM(pA0, pA1, alA, l_reg, pa0, pa1, pa2, pa3); SBAR();
    MK_PV(o, VSLOT(NT - 2), pa0, pa1, pa2, pa3);
    MASKT(pB0, pB1, NT - 1); partialSM(pB0, pB1, m_reg, mnB, alB); RBAR(); RESC(alB);
    finishSM(pB0, pB1, alB, l_reg, pa0, pa1, pa2, pa3); SBAR(); MK_PV(o, VSLOT(NT - 1), pa0, pa1, pa2, pa3);
    if (hi == 0) li_l[r32] = l_reg; asm volatile("s_waitcnt lgkmcnt(0)" ::: "memory");
#pragma unroll
    for (int r = 0; r < 16; ++r) { const float rl = __builtin_amdgcn_rcpf(li_l[crow(r, hi)]);
#pragma unroll
        for (int d0 = 0; d0 < 4; ++d0) o[d0][r] *= rl; }
    WAITV(0); RBAR();
    float* X = (float*)lds + rg * 4096;
    if (mp == 1) {
#pragma unroll
        for (int d0 = 0; d0 < 4; ++d0)
#pragma unroll
            for (int r = 0; r < 16; ++r) X[(d0 * 16 + r) * 64 + lane] = o[d0][r];
    }
    RBAR();
    if (mp == 0) {
        float gs[4];
#pragma unroll
        for (int d0 = 0; d0 < 4; ++d0) gs[d0] = gsub[d0 * 32 + r32] * 0.8f;
#pragma unroll
        for (int r = 0; r < 16; ++r) {
            float y[4]; float ss = 0.f;
#pragma unroll
            for (int d0 = 0; d0 < 4; ++d0) { y[d0] = o[d0][r] - lam * X[(d0 * 16 + r) * 64 + lane]; ss += y[d0] * y[d0]; }
            ss += __shfl_xor(ss, 1); ss += __shfl_xor(ss, 2); ss += __shfl_xor(ss, 4); ss += __shfl_xor(ss, 8); ss += __shfl_xor(ss, 16);
            const float sc_ = __builtin_amdgcn_rsqf(ss * (1.0f / 128.0f) + 1e-6f);
            bf16_t* orow = AO + (size_t)(seq0 + qlo + crow(r, hi)) * 2048 + h * 128;
#pragma unroll
            for (int d0 = 0; d0 < 4; ++d0) { const float v = y[d0] * sc_ * gs[d0]; const float vn = __shfl_xor(v, 1);
                if ((r32 & 1) == 0) *(unsigned*)(orow + d0 * 32 + r32) = cvtpk(v, vn); }
        }
    }
    RBAR();
#undef DMA_TILE
#undef WAITV
#undef RBAR
#undef KSLOT
#undef VSLOT
#undef TB0
#undef MASKT
#undef RESC
#undef HALF_STEP_A
#undef HALF_STEP_B
}

typedef short s16x4b __attribute__((ext_vector_type(4)));
__device__ __forceinline__ void decode_unit(int b, int chunk, const float* __restrict__ cache_k, const float* __restrict__ cache_v, const int* __restrict__ page_table,
                                            const bf16_t* QB, float* DPO, float* DPM, float* DPL, char* lds) {
    typedef __attribute__((address_space(3))) s16x4b* lds_v4p;
    int tid_l = threadIdx.x; asm volatile("" : "+v"(tid_l));
    const int tid = tid_l, h = __builtin_amdgcn_readfirstlane(tid >> 6), lane = tid & 63, n = lane & 15, g = lane >> 4;
    const int unit = b * 32 + chunk;
    bf16x8 qf[4];
    { const int mq = n >> 3, tq = n & 7;
#pragma unroll
      for (int s4 = 0; s4 < 4; ++s4) { bf16x8 z = {0, 0, 0, 0, 0, 0, 0, 0};
          if ((s4 >> 1) == mq) z = *reinterpret_cast<const bf16x8*>(QB + (size_t)(mk::MP + b * 8 + tq) * 1024 + h * 128 + s4 * 32 + 8 * g);
          qf[s4] = z; } }
    const float slope_l2 = __builtin_amdgcn_exp2f(-(float)(h + 1)) * mk::LOG2E;
    float m_run = -1e30f, l_run = 0.f; f32x4 o[8];
#pragma unroll
    for (int i = 0; i < 8; ++i) o[i] = (f32x4){0.f, 0.f, 0.f, 0.f};
    f32x4 kA[8], vA[8], kB[8], vB[8];
    const int wtok = tid >> 8, whh = (tid & 255) >> 5, wd = (tid & 31) * 4;
    int pgs[4];
#pragma unroll
    for (int i = 0; i < 4; ++i) pgs[i] = page_table[b * mk::NPAGES + chunk * 4 + i];
#define DLOADS(s, KR, VR) do { const int si_ = (s) >> 3; const int pg_ = si_ == 0 ? pgs[0] : si_ == 1 ? pgs[1] : si_ == 2 ? pgs[2] : pgs[3]; const size_t base_ = (size_t)pg_ * 131072 + (size_t)((s) & 7) * 16384 + (size_t)tid * 4; \
        _Pragma("unroll") for (int i = 0; i < 8; ++i) { KR[i] = __builtin_nontemporal_load((const f32x4*)(cache_k + base_ + i * 2048)); VR[i] = __builtin_nontemporal_load((const f32x4*)(cache_v + base_ + i * 2048)); } } while (0)
    constexpr int DROW = 272, DHEAD = 16 * DROW, DBUF = 2 * 8 * DHEAD;
    char* const wbase = lds + whh * DHEAD + wtok * DROW + wd * 2;
#define DWRITES(buf, KR, VR) do { _Pragma("unroll") for (int i = 0; i < 8; ++i) { \
        uint2 kw_, vw_; kw_.x = cvtpk(KR[i][0], KR[i][1]); kw_.y = cvtpk(KR[i][2], KR[i][3]); vw_.x = cvtpk(VR[i][0], VR[i][1]); vw_.y = cvtpk(VR[i][2], VR[i][3]); \
        *(uint2*)(wbase + (buf) * DBUF + i * 2 * DROW) = kw_; \
        *(uint2*)(wbase + (buf) * DBUF + 8 * DHEAD + i * 2 * DROW) = vw_; } } while (0)
    const int tq_ = n >> 2, tp_ = n & 3;
#define DCOMPUTE(s) do { \
            const char* Kb = lds + ((s) & 1) * DBUF + h * DHEAD + n * DROW + 16 * g; const char* Vb = lds + ((s) & 1) * DBUF + 8 * DHEAD + h * DHEAD + (4 * g + tq_) * DROW + 8 * tp_; \
            f32x4 S = (f32x4){0.f, 0.f, 0.f, 0.f}; \
            _Pragma("unroll") for (int s4 = 0; s4 < 4; ++s4) { \
                const bf16x8 a = *reinterpret_cast<const bf16x8*>(Kb + s4 * 64); \
                S = __builtin_amdgcn_mfma_f32_16x16x32_bf16(a, qf[s4], S, 0, 0, 0); } \
            const int kpos0 = (chunk * 4 + ((s) >> 3)) * mk::PAGE + ((s) & 7) * 16 - mk::PAST + 4 * g; \
            float s2[4]; \
            _Pragma("unroll") for (int r = 0; r < 4; ++r) s2[r] = S[r] * (SCALE * mk::LOG2E) + slope_l2 * (float)(kpos0 + r); \
            float mx = fmaxf(fmaxf(s2[0], s2[1]), fmaxf(s2[2], s2[3])); \
            mx = fmaxf(mx, __shfl_xor(mx, 16)); mx = fmaxf(mx, __shfl_xor(mx, 32)); \
            const float mnew = fmaxf(m_run, mx), alpha = __builtin_amdgcn_exp2f(m_run - mnew); m_run = mnew; \
            float p[4]; \
            _Pragma("unroll") for (int r = 0; r < 4; ++r) p[r] = __builtin_amdgcn_exp2f(s2[r] - mnew); \
            l_run = l_run * alpha + ((p[0] + p[1]) + (p[2] + p[3])); \
            uint2 pw; pw.x = cvtpk(p[0], p[1]); pw.y = cvtpk(p[2], p[3]); \
            const s16x4b pa = __builtin_bit_cast(s16x4b, pw); \
            if (__any(alpha < 1.f)) { \
                const float a0 = __shfl(alpha, 4 * g + 0), a1 = __shfl(alpha, 4 * g + 1), a2 = __shfl(alpha, 4 * g + 2), a3 = __shfl(alpha, 4 * g + 3); \
                _Pragma("unroll") for (int i = 0; i < 8; ++i) { o[i][0] *= a0; o[i][1] *= a1; o[i][2] *= a2; o[i][3] *= a3; } } \
            _Pragma("unroll") for (int blk = 0; blk < 8; ++blk) { \
                const s16x4b vf = __builtin_bit_cast(s16x4b, __builtin_amdgcn_ds_read_tr16_b64_v4i16((lds_v4p)(Vb + blk * 32))); \
                o[blk] = __builtin_amdgcn_mfma_f32_16x16x16bf16_1k(pa, vf, o[blk], 0, 0, 0); } } while (0)
#define VMWN(N) asm volatile("s_waitcnt vmcnt(" #N ")" ::: "memory")
    DLOADS(0, kA, vA); DLOADS(1, kB, vB);
    VMWN(16); DWRITES(0, kA, vA);
    __syncthreads();
#ifndef MK_DEC_DEPTH
#define MK_DEC_DEPTH 2
#endif
    for (int s = 0; s < 32; s += 2) {
        if (MK_DEC_DEPTH == 2) { if (s + 2 < 32) DLOADS(s + 2, kA, vA); }
        DCOMPUTE(s);
        if (MK_DEC_DEPTH == 2 && s + 2 < 32) { VMWN(16); } else { VMWN(0); }
        DWRITES(1, kB, vB);
        if (MK_DEC_DEPTH == 1) { if (s + 2 < 32) DLOADS(s + 2, kA, vA); }
        __syncthreads();
        if (MK_DEC_DEPTH == 2) { if (s + 3 < 32) DLOADS(s + 3, kB, vB); }
        DCOMPUTE(s + 1);
        if (s + 2 < 32) { if (MK_DEC_DEPTH == 2 && s + 3 < 32) { VMWN(16); } else { VMWN(0); } DWRITES(0, kA, vA); }
        if (MK_DEC_DEPTH == 1) { if (s + 3 < 32) DLOADS(s + 3, kB, vB); }
        __syncthreads();
    }
#undef VMWN
#undef DCOMPUTE
    l_run += __shfl_xor(l_run, 16); l_run += __shfl_xor(l_run, 32);
    if (g == 0) { DPM[(unit * 8 + h) * 16 + n] = m_run; DPL[(unit * 8 + h) * 16 + n] = l_run; }
#pragma unroll
    for (int blk = 0; blk < 8; ++blk)
#pragma unroll
        for (int r = 0; r < 4; ++r) DPO[((size_t)(unit * 8 + h) * 16 + (4 * g + r)) * 128 + 16 * blk + n] = o[blk][r];
#undef DLOADS
#undef DWRITES
}
__device__ __forceinline__ float wsum(float v) {
#pragma unroll
    for (int o = 1; o < 64; o <<= 1) v += __shfl_xor(v, o);
    return v;
}
__device__ __forceinline__ float row16_sum(float v) {
    v += __builtin_bit_cast(float, __builtin_amdgcn_update_dpp(0, __builtin_bit_cast(int, v), 0xB1, 0xF, 0xF, true));
    v += __builtin_bit_cast(float, __builtin_amdgcn_update_dpp(0, __builtin_bit_cast(int, v), 0x4E, 0xF, 0xF, true));
    v += __builtin_bit_cast(float, __builtin_amdgcn_update_dpp(0, __builtin_bit_cast(int, v), 0x141, 0xF, 0xF, true));
    v += __builtin_bit_cast(float, __builtin_amdgcn_update_dpp(0, __builtin_bit_cast(int, v), 0x128, 0xF, 0xF, true));
    return v;
}
__device__ __forceinline__ float wave_sum_dpp(float v) {
    v = row16_sum(v);
    const int vi = __builtin_bit_cast(int, v);
    return (__builtin_bit_cast(float, __builtin_amdgcn_readlane(vi, 0)) + __builtin_bit_cast(float, __builtin_amdgcn_readlane(vi, 16))) +
           (__builtin_bit_cast(float, __builtin_amdgcn_readlane(vi, 32)) + __builtin_bit_cast(float, __builtin_amdgcn_readlane(vi, 48)));
}
__device__ __forceinline__ void decode_combine(int item, const bf16_t* QB, const bf16_t* KBp, const bf16_t* VBp, const float* DPO, const float* DPM, const float* DPL,
                                               bf16_t* AO, float lam, const float* gsub, int lane) {
    const int b = item >> 6, h = (item >> 3) & 7, t = item & 7, row = mk::MP + b * 8 + t;
    const float slope_l2 = __builtin_amdgcn_exp2f(-(float)(h + 1)) * mk::LOG2E;
    const int mh = lane >> 5, u = lane & 31, pil = ((b * 32 + u) * 8 + h) * 16 + mh * 8 + t;
    const float pm = DPM[pil], pl = DPL[pil];
    float sn0[8], sn1[8];
#pragma unroll
    for (int m = 0; m < 2; ++m) {
        const float qv = bf2f(QB[(size_t)row * 1024 + h * 128 + m * 64 + lane]);
        float pr[8];
#pragma unroll
        for (int t2 = 0; t2 < 8; ++t2) pr[t2] = wave_sum_dpp(qv * bf2f(KBp[(size_t)(mk::MP + b * 8 + t2) * 1024 + h * 128 + m * 64 + lane]));
#pragma unroll
        for (int t2 = 0; t2 < 8; ++t2) { const float sv = pr[t2] * (SCALE * mk::LOG2E) + slope_l2 * (float)t2; if (m == 0) sn0[t2] = sv; else sn1[t2] = sv; }
    }
    float M = pm;
#pragma unroll
    for (int o_ = 1; o_ < 32; o_ <<= 1) M = fmaxf(M, __shfl_xor(M, o_));
#pragma unroll
    for (int t2 = 0; t2 < 8; ++t2) if (t2 <= t) M = fmaxf(M, mh ? sn1[t2] : sn0[t2]);
    const float w = __builtin_amdgcn_exp2f(pm - M);
    float L = pl * w;
#pragma unroll
    for (int o_ = 1; o_ < 32; o_ <<= 1) L += __shfl_xor(L, o_);
#pragma unroll
    for (int t2 = 0; t2 < 8; ++t2) if (t2 <= t) L += __builtin_amdgcn_exp2f((mh ? sn1[t2] : sn0[t2]) - M);
    float on[2][2];
#pragma unroll
    for (int m = 0; m < 2; ++m) {
        const float Mm = __builtin_bit_cast(float, __builtin_amdgcn_readlane(__builtin_bit_cast(int, M), m * 32)), Lm = __builtin_bit_cast(float, __builtin_amdgcn_readlane(__builtin_bit_cast(int, L), m * 32));
        float O0 = 0.f, O1 = 0.f;
#pragma unroll
        for (int uu = 0; uu < 32; ++uu) { const float wv = __builtin_bit_cast(float, __builtin_amdgcn_readlane(__builtin_bit_cast(int, w), m * 32 + uu));
            const float2 ov = *(const float2*)(DPO + (size_t)(((b * 32 + uu) * 8 + h) * 16 + m * 8 + t) * 128 + 2 * lane); O0 += ov.x * wv; O1 += ov.y * wv; }
#pragma unroll
        for (int t2 = 0; t2 < 8; ++t2) if (t2 <= t) { const float p = __builtin_amdgcn_exp2f((m == 0 ? sn0[t2] : sn1[t2]) - Mm);
            const unsigned vv = *(const unsigned*)(VBp + (size_t)(mk::MP + b * 8 + t2) * 1024 + h * 128 + 2 * lane);
            O0 += p * __uint_as_float(vv << 16); O1 += p * __uint_as_float(vv & 0xffff0000u); }
        const float rl = 1.0f / Lm; on[m][0] = O0 * rl; on[m][1] = O1 * rl;
    }
    const float y0 = on[0][0] - lam * on[1][0], y1 = on[0][1] - lam * on[1][1];
    const float ss = wsum(y0 * y0 + y1 * y1);
    const float sc_ = __builtin_amdgcn_rsqf(ss * (1.0f / 128.0f) + 1e-6f) * 0.8f;
    const float2 gg = *(const float2*)(gsub + 2 * lane);
    *(unsigned*)(AO + (size_t)row * 2048 + h * 128 + 2 * lane) = cvtpk(y0 * sc_ * gg.x, y1 * sc_ * gg.y);
}

__device__ __forceinline__ void conv_unit(int unit, const bf16_t* U, const float* state_conv, const float* w_dw, const float* b_dw, const float* g_cn, const float* b_cn, bf16_t* AO, char* lds) {
    int tid_l = threadIdx.x; asm volatile("" : "+v"(tid_l));
    const int tid = tid_l, wid = __builtin_amdgcn_readfirstlane(tid >> 6), lane = tid & 63;
    float* T = (float*)lds;
    const bool samp = unit >= 512;
    int grp, row0, nrows, t0 = 0, bs = 0;
    if (!samp) { grp = unit & 7; const int tile = unit >> 3; row0 = tile * 128; t0 = row0 & 2047; nrows = 158; }
    else { const int su = unit - 512; grp = su & 7; bs = su >> 3; row0 = mk::MP + bs * 8; nrows = 38; }
    const int ch = grp * 128 + 2 * lane;
    float2 w[31];
#pragma unroll
    for (int j = 0; j < 31; ++j) w[j] = *(const float2*)(w_dw + (size_t)j * 1024 + ch);
    const float2 bd = *(const float2*)(b_dw + ch), gc = *(const float2*)(g_cn + ch), bc = *(const float2*)(b_cn + ch);
    {
        f32x4 fa[5], fb[5];
#pragma unroll
        for (int it = 0; it < 5; ++it) {
            const int idx = tid + 512 * it, i = idx >> 4, c8 = (idx & 15) * 8, tau = i - 30; f32x4 va = (f32x4){0.f, 0.f, 0.f, 0.f}, vb = va;
            if (idx < nrows * 16) {
                if (samp && tau < 0) { const float* sp = state_conv + (size_t)(bs * 30 + 30 + tau) * 1024 + grp * 128 + c8; va = *(const f32x4*)sp; vb = *(const f32x4*)(sp + 4); }
                else if (samp || t0 + tau >= 0) { const u32x4 w_ = *(const u32x4*)(U + (size_t)(row0 + tau) * 1024 + grp * 128 + c8);
                    va = (f32x4){__uint_as_float(w_.x << 16), __uint_as_float(w_.x & 0xffff0000u), __uint_as_float(w_.y << 16), __uint_as_float(w_.y & 0xffff0000u)};
                    vb = (f32x4){__uint_as_float(w_.z << 16), __uint_as_float(w_.z & 0xffff0000u), __uint_as_float(w_.w << 16), __uint_as_float(w_.w & 0xffff0000u)}; }
            }
            fa[it] = va; fb[it] = vb;
        }
#pragma unroll
        for (int it = 0; it < 5; ++it) { const int idx = tid + 512 * it; if (idx < nrows * 16) { float* d = T + (idx >> 4) * 128 + (idx & 15) * 8; *(f32x4*)d = fa[it]; *(f32x4*)(d + 4) = fb[it]; } }
    }
    __syncthreads();
    const int ngrp = samp ? 1 : 4, tokb = samp ? wid : wid * 16;
    for (int k4 = 0; k4 < ngrp; ++k4) {
        float a0[4], a1[4];
#pragma unroll
        for (int q = 0; q < 4; ++q) { a0[q] = bd.x; a1[q] = bd.y; }
#pragma unroll
        for (int j = 0; j < 34; ++j) {
            const float2 x = *(const float2*)(T + (tokb + 4 * k4 + j) * 128 + 2 * lane);
#pragma unroll
            for (int q = 0; q < 4; ++q) if (j - q >= 0 && j - q < 31) { a0[q] = fmaf(w[j - q].x, x.x, a0[q]); a1[q] = fmaf(w[j - q].y, x.y, a1[q]); }
        }
#pragma unroll
        for (int q = 0; q < 4; ++q) {
            if (samp && q > 0) break;
            const int tt = tokb + 4 * k4 + q;
            const float mean = wave_sum_dpp(a0[q] + a1[q]) * (1.0f / 128.0f);
            const float d0 = a0[q] - mean, d1 = a1[q] - mean;
            const float rs = __builtin_amdgcn_rsqf(wave_sum_dpp(d0 * d0 + d1 * d1) * (1.0f / 128.0f) + 1e-5f);
            const float y0 = d0 * rs * gc.x + bc.x, y1 = d1 * rs * gc.y + bc.y;
            const float o0 = y0 * __builtin_amdgcn_rcpf(1.0f + __builtin_amdgcn_exp2f(-y0 * mk::LOG2E)), o1 = y1 * __builtin_amdgcn_rcpf(1.0f + __builtin_amdgcn_exp2f(-y1 * mk::LOG2E));
            *(unsigned*)(AO + (size_t)(row0 + tt) * 2048 + 1024 + ch) = cvtpk(o0, o1);
        }
    }
    __syncthreads();
}
#undef VMW
#undef SBAR
#undef KSWZ
}
namespace sk {
typedef short bf16x8 __attribute__((ext_vector_type(8)));
typedef float f32x4 __attribute__((ext_vector_type(4)));
typedef unsigned short bf16_t;
__device__ __forceinline__ float ssq8(const bf16x8 a) {
    const uint4 w = __builtin_bit_cast(uint4, a); float s = 0.f;
    { const float lo = __uint_as_float(w.x << 16), hi = __uint_as_float(w.x & 0xffff0000u); s = fmaf(lo, lo, s); s = fmaf(hi, hi, s); }
    { const float lo = __uint_as_float(w.y << 16), hi = __uint_as_float(w.y & 0xffff0000u); s = fmaf(lo, lo, s); s = fmaf(hi, hi, s); }
    { const float lo = __uint_as_float(w.z << 16), hi = __uint_as_float(w.z & 0xffff0000u); s = fmaf(lo, lo, s); s = fmaf(hi, hi, s); }
    { const float lo = __uint_as_float(w.w << 16), hi = __uint_as_float(w.w & 0xffff0000u); s = fmaf(lo, lo, s); s = fmaf(hi, hi, s); }
    return s;
}
__device__ __forceinline__ unsigned short f2bf(float f) { unsigned u = __builtin_bit_cast(unsigned, f); return (unsigned short)((u + 0x7fffu + ((u >> 16) & 1u)) >> 16); }
__device__ __forceinline__ void pos_rc(int tid, int i, int& row, int& col) { const int p = tid + 512 * i, rb = p >> 8, q = p & 255, l = q & 63; row = rb * 16 + 4 * (l >> 4) + (q >> 6); col = l & 15; }

template <int RB, int NACC, bool STATS, int K>
__device__ __forceinline__ void tile(const bf16_t* A, const bf16_t* B0, const bf16_t* B1, char* lds, float (&v)[RB / 2][NACC], float (&rs)[RB / 2]) {
    int tid_l = threadIdx.x; asm volatile("" : "+v"(tid_l));
    const int tid = tid_l, wave = __builtin_amdgcn_readfirstlane(tid >> 6), lane = tid & 63, n = lane & 15, g = lane >> 4;
    constexpr int per = (K / 32) / 8;
    constexpr int BATCH = (RB * NACC >= 8) ? 2 : (RB >= 4 ? 4 : (per > 8 ? (per + 1) / 2 : 8));
    f32x4 acc[NACC][RB]; float ssq[RB];
#pragma unroll
    for (int s = 0; s < NACC; ++s)
#pragma unroll
        for (int rb = 0; rb < RB; ++rb) acc[s][rb] = (f32x4){0.f, 0.f, 0.f, 0.f};
#pragma unroll
    for (int rb = 0; rb < RB; ++rb) ssq[rb] = 0.f;
    const bf16_t* ap = A + (size_t)n * K + 8 * g + (size_t)wave * per * 32;
    const bf16_t* bp0 = B0 + (size_t)n * K + 8 * g + (size_t)wave * per * 32;
    const bf16_t* bp1 = (NACC == 2 ? B1 : B0) + (size_t)n * K + 8 * g + (size_t)wave * per * 32;
    constexpr int BD = (BATCH + 1) / 2;
    bf16x8 bf[2][BD][NACC], af[2][BD][RB];
#define SK_LOADB(buf, kb) do { _Pragma("unroll") for (int j = 0; j < BD; ++j) if ((kb) + j < per) { \
            bf[buf][j][0] = *reinterpret_cast<const bf16x8*>(bp0 + ((kb) + j) * 32); \
            if (NACC == 2) bf[buf][j][NACC - 1] = *reinterpret_cast<const bf16x8*>(bp1 + ((kb) + j) * 32); \
            _Pragma("unroll") for (int rb = 0; rb < RB; ++rb) af[buf][j][rb] = *reinterpret_cast<const bf16x8*>(ap + (size_t)rb * 16 * K + ((kb) + j) * 32); } } while (0)
    SK_LOADB(0, 0);
#pragma unroll
    for (int k0 = 0; k0 < per; k0 += BD) {
        const int cb = (k0 / BD) & 1;
        if (k0 + BD < per) { if (cb == 0) SK_LOADB(1, k0 + BD); else SK_LOADB(0, k0 + BD); }
        __builtin_amdgcn_sched_barrier(0);
#pragma unroll
        for (int j = 0; j < BD; ++j) if (k0 + j < per) {
#pragma unroll
            for (int rb = 0; rb < RB; ++rb) {
                if (STATS) ssq[rb] += ssq8(cb == 0 ? af[0][j][rb] : af[1][j][rb]);
#pragma unroll
                for (int s = 0; s < NACC; ++s) acc[s][rb] = __builtin_amdgcn_mfma_f32_16x16x32_bf16(cb == 0 ? af[0][j][rb] : af[1][j][rb], cb == 0 ? bf[0][j][s] : bf[1][j][s], acc[s][rb], 0, 0, 0);
            }
        }
        __builtin_amdgcn_sched_barrier(0);
    }
#undef SK_LOADB
    float* red = (float*)lds; float* redS = red + 8 * NACC * RB * 256;
#pragma unroll
    for (int s = 0; s < NACC; ++s)
#pragma unroll
        for (int rb = 0; rb < RB; ++rb)
#pragma unroll
            for (int r = 0; r < 4; ++r) red[(((wave * NACC + s) * RB + rb) * 4 + r) * 64 + lane] = acc[s][rb][r];
    if (STATS) {
#pragma unroll
        for (int rb = 0; rb < RB; ++rb) { float q = ssq[rb]; q += __shfl_xor(q, 16); q += __shfl_xor(q, 32); if (g == 0) redS[wave * (RB * 16) + rb * 16 + n] = q; }
    }
    __syncthreads();
#pragma unroll
    for (int i = 0; i < RB / 2; ++i) {
        const int p = tid + 512 * i, rb = p >> 8, q = p & 255;
#pragma unroll
        for (int s = 0; s < NACC; ++s) { float sum = 0.f;
#pragma unroll
            for (int w = 0; w < 8; ++w) sum += red[((w * NACC + s) * RB + rb) * 256 + q];
            v[i][s] = sum; }
        if (STATS) { const int l = q & 63, rl = rb * 16 + 4 * (l >> 4) + (q >> 6); float sum = 0.f;
#pragma unroll
            for (int w = 0; w < 8; ++w) sum += redS[w * (RB * 16) + rl];
            rs[i] = __builtin_amdgcn_rsqf(sum / (float)K + 1e-6f); }
        else rs[i] = 1.f;
    }
    __syncthreads();
}
__device__ __forceinline__ float sigm(float x) { return __builtin_amdgcn_rcpf(1.0f + __builtin_amdgcn_exp2f(-x * 1.4426950408889634f)); }

#define SK_DEAL(nchunks, slack) int c0_, cs_; if ((slack) && G == 256) { c0_ = bx - 128; cs_ = 128; } else { c0_ = bx; cs_ = G; } for (int c = c0_; c >= 0 && c < (nchunks); c += cs_)

__device__ __forceinline__ void swiglu_phase(const bf16_t* A, const bf16_t* Wt, bf16_t* ACTs, int bx, int G, char* lds) {
    SK_DEAL(352, true) {
        const int col0 = c * 16; const bf16_t* Bg = Wt + (size_t)(256 * (col0 >> 7) + (col0 & 127)) * 2048;
        float v[2][2], rs[2]; tile<4, 2, true, 2048>(A, Bg, Bg + (size_t)128 * 2048, lds, v, rs);
#pragma unroll
        for (int i = 0; i < 2; ++i) { int row, col; pos_rc(threadIdx.x, i, row, col); const float g = v[i][0] * rs[i], u = v[i][1] * rs[i];
            ACTs[(size_t)row * 5632 + col0 + col] = f2bf(g * sigm(g) * u); }
    }
}
template <int ALPHA2, int K>
__device__ __forceinline__ void resid_phase(const bf16_t* A, const bf16_t* Wt, const bf16_t* resid, bf16_t* Hbs, int bx, int G, char* lds) {
    SK_DEAL(256, false) {
        const int col0 = (c & 127) * 16, row0 = (c >> 7) * 32;
        int row, col; pos_rc(threadIdx.x, 0, row, col); const size_t o = (size_t)(row0 + row) * 2048 + col0 + col;
        const bf16_t rv = resid[o];
        float v[1][1], rs[1]; tile<2, 1, false, K>(A + (size_t)row0 * K, Wt + (size_t)col0 * K, nullptr, lds, v, rs);
        Hbs[o] = f2bf(__uint_as_float((unsigned)rv << 16) + (0.5f * ALPHA2) * v[0][0]);
    }
}
__device__ __forceinline__ void win_phase(const bf16_t* A, const bf16_t* Wt, bf16_t* Qs, size_t qkv_stride, bf16_t* Us, float* out, int bx, int G, char* lds) {
    SK_DEAL(256, true) {
        if (c < 192) {
            const int col0 = c * 16; float v[2][1], rs[2]; tile<4, 1, true, 2048>(A, Wt + (size_t)col0 * 2048, nullptr, lds, v, rs);
            const int t = col0 >> 10, cc = col0 & 1023;
#pragma unroll
            for (int i = 0; i < 2; ++i) { int row, col; pos_rc(threadIdx.x, i, row, col); const float x = v[i][0] * rs[i];
                Qs[(size_t)t * qkv_stride + (size_t)row * 1024 + cc + col] = f2bf(x);
                if (t) out[mk::OK_S + (size_t)(t - 1) * (mk::MS * 1024) + (size_t)row * 1024 + cc + col] = x; }
        } else {
            const int j0 = (c - 192) * 16; const bf16_t* Ba = Wt + (size_t)(3072 + 256 * (j0 >> 7) + (j0 & 127)) * 2048;
            float v[2][2], rs[2]; tile<4, 2, true, 2048>(A, Ba, Ba + (size_t)128 * 2048, lds, v, rs);
#pragma unroll
            for (int i = 0; i < 2; ++i) { int row, col; pos_rc(threadIdx.x, i, row, col); const float u = v[i][0] * rs[i] * sigm(v[i][1] * rs[i]);
                Us[(size_t)row * 1024 + j0 + col] = f2bf(u);
                out[mk::OC_S + (size_t)((row >> 3) * 30 + 22 + (row & 7)) * 1024 + j0 + col] = u; }
        }
    }
}
__device__ __forceinline__ void ple_phase(const bf16_t* H3b, const bf16_t* Wg, const bf16_t* Pb, const bf16_t* Wp, bf16_t* H4s, int bx, int G, char* lds) {
    SK_DEAL(256, false) {
        const int col0 = (c & 127) * 16, row0 = (c >> 7) * 32;
        float vg[1][1], rg[1], vp[1][1], rp[1];
        tile<2, 1, true, 2048>(H3b + (size_t)row0 * 2048, Wg + (size_t)col0 * 2048, nullptr, lds, vg, rg);
        tile<2, 1, false, 256>(Pb + (size_t)row0 * 256, Wp + (size_t)col0 * 256, nullptr, lds, vp, rp);
        int row, col; pos_rc(threadIdx.x, 0, row, col); const size_t o = (size_t)(row0 + row) * 2048 + col0 + col;
        H4s[o] = f2bf(__uint_as_float((unsigned)H3b[o] << 16) + vp[0][0] * sigm(vg[0][0] * rg[0]));
    }
}
#undef SK_DEAL
}
namespace mk {
constexpr int NWAVES = 8;
constexpr size_t MiB = 1u << 20;
constexpr size_t WS_CTL = 0, CTL_ZERO_BYTES = 1 * MiB;
constexpr size_t WS_W1T = 1 * MiB;
constexpr size_t WS_W2T = WS_W1T + 44 * MiB;
constexpr size_t WS_WINT = WS_W2T + 22 * MiB;
constexpr size_t WS_WOT = WS_WINT + 20 * MiB;
constexpr size_t WS_W3T = WS_WOT + 8 * MiB;
constexpr size_t WS_W4T = WS_W3T + 44 * MiB;
constexpr size_t WS_WPGT = WS_W4T + 22 * MiB;
constexpr size_t WS_WPPT = WS_WPGT + 8 * MiB;
constexpr size_t WS_XB = WS_WPPT + 1 * MiB;
constexpr size_t WS_PB = WS_XB + 33 * MiB;
constexpr size_t WS_ACT = WS_PB + 5 * MiB;
constexpr size_t WS_H1B = WS_ACT + 91 * MiB;
constexpr size_t WS_QB = WS_H1B + 33 * MiB;
constexpr size_t WS_KB = WS_QB + 17 * MiB;
constexpr size_t WS_VB = WS_KB + 17 * MiB;
constexpr size_t WS_U = WS_VB + 17 * MiB;
constexpr size_t WS_AO = WS_U + 33 * MiB;
constexpr size_t WS_H2B = WS_AO + 33 * MiB;
constexpr size_t WS_H3B = WS_H2B + 33 * MiB;
constexpr size_t WS_PJ = WS_H3B + 33 * MiB;
constexpr size_t WS_H4 = WS_PJ + 33 * MiB;
constexpr size_t WS_ST1 = WS_H4 + 66 * MiB;
constexpr size_t WS_ST2 = WS_ST1 + 1 * MiB;
constexpr size_t WS_ST3 = WS_ST2 + 1 * MiB;
constexpr size_t WS_ST4 = WS_ST3 + 1 * MiB;
constexpr size_t WS_DPO = WS_ST4 + 1 * MiB;
constexpr size_t WS_DPM = WS_DPO + 16 * MiB;
constexpr size_t WS_DPL = WS_DPM + 1 * MiB;
constexpr size_t WS_END = WS_DPL + 1 * MiB;
static_assert((size_t)MPAD * 2048 * 2 <= 33 * MiB && (size_t)MPAD * 5632 * 2 <= 91 * MiB && (size_t)MPAD * 2048 * 4 <= 66 * MiB && (size_t)MPAD * 1024 * 2 <= 17 * MiB, "ws map");
constexpr int CW_SEAM = 8192;
constexpr int CW_BAR = 4096;
constexpr int RING_BYTES = 131072, PST_OFF = RING_BYTES, MISC_OFF = 143360, LDS_BYTES = 147456 + 1024;
static_assert(PG8_PF_DUMMY + 256 <= LDS_BYTES && PG8_PF_DUMMY >= MISC_OFF + 4096, "prefetch dummy block");
static_assert(8 * 16896 <= MISC_OFF && 2 * 69632 <= MISC_OFF, "phase scratch below the control words");
}


namespace mk {
__device__ __forceinline__ float wave_sum(float v) {
#pragma unroll
    for (int o = 1; o < 64; o <<= 1) v += __shfl_xor(v, o);
    return v;
}
struct TrD { const float* src; const float* gain; bf16* dst; int N, K; };
__device__ __forceinline__ TrD tr_desc(const float* W, const float* gain, int K, int N, bf16* WT, int mode, int item) {
    const int nblk = N / 32, kb = item / nblk, nb = item % nblk, k0 = 64 * kb, n0 = 32 * nb;
    int dr = n0;
    if (mode == 1 || mode == 2) dr = 256 * (n0 >> 7) + 128 * (mode - 1) + (n0 & 127);
    else if (mode == 3 && n0 >= 3072) { const int j = n0 - 3072, half = j >> 10, jj = j & 1023; dr = 3072 + 256 * (jj >> 7) + 128 * half + (jj & 127); }
    TrD d; d.src = W + (size_t)k0 * N + n0; d.gain = gain ? gain + k0 : nullptr; d.dst = WT + (size_t)dr * K + k0; d.N = N; d.K = K; return d;
}
__device__ __forceinline__ void tr_load(const TrD& d, f32x4 (&t)[8], int lane) {
    const float* src = d.src + (size_t)(lane >> 3) * d.N + (lane & 7) * 4;
#pragma unroll
    for (int i = 0; i < 8; ++i) t[i] = __builtin_nontemporal_load((const GAS f32x4*)(src + (size_t)(8 * i) * d.N));
}
__device__ __forceinline__ void tr_store(const TrD& d, const f32x4 (&t)[8], LAS float* scr, int lane) {
    const int c = lane & 7;
    float gv[8];
#pragma unroll
    for (int j = 0; j < 8; ++j) gv[j] = d.gain ? d.gain[8 * c + j] : 1.0f;
#pragma unroll
    for (int i = 0; i < 8; ++i) { LAS float* p = scr + (8 * i + (lane >> 3)) * 33 + (lane & 7) * 4; p[0] = t[i].x; p[1] = t[i].y; p[2] = t[i].z; p[3] = t[i].w; }
    LDS_WAIT(); asm volatile("" ::: "memory");
#pragma unroll
    for (int j = 0; j < 4; ++j) { const int n = (lane >> 3) + 8 * j; const LAS float* s_ = scr + (8 * c) * 33 + n;
        v4u o; o.x = pk2(s_[0 * 33] * gv[0], s_[1 * 33] * gv[1]); o.y = pk2(s_[2 * 33] * gv[2], s_[3 * 33] * gv[3]); o.z = pk2(s_[4 * 33] * gv[4], s_[5 * 33] * gv[5]); o.w = pk2(s_[6 * 33] * gv[6], s_[7 * 33] * gv[7]);
        *(GAS v4u*)(d.dst + (size_t)n * d.K + 8 * c) = o; }
    LDS_WAIT(); asm volatile("" ::: "memory");
}
#define TR_STREAM(NIT, w0, ws, DESC) do { LAS float* scrA_ = (LAS float*)(ldsl + wave * 16896); LAS float* scrB_ = scrA_ + 64 * 33;     \
    for (int it_ = (w0); it_ >= 0 && it_ < (NIT); it_ += 2 * (ws)) { const bool hb_ = it_ + (ws) < (NIT); const TrD da_ = DESC(it_); const TrD db_ = DESC(hb_ ? it_ + (ws) : it_); \
        f32x4 ta_[8], tb_[8]; tr_load(da_, ta_, lane); if (hb_) tr_load(db_, tb_, lane); tr_store(da_, ta_, scrA_, lane); if (hb_) tr_store(db_, tb_, scrB_, lane); } } while (0)

struct Args { const void* in[32]; float* out; unsigned char* ws; int ph_lo, ph_hi; };
constexpr int N_PHASES = 11;

__global__ void __launch_bounds__(NWAVES * 64, 2) hymba_fwd(Args args) {
    extern __shared__ __attribute__((aligned(16))) unsigned char lds[];
    LAS unsigned char* ldsl = (LAS unsigned char*)lds;
    volatile LAS unsigned* MISC = (volatile LAS unsigned*)(ldsl + MISC_OFF);
#define LOCAL_IDS() int tid_l = threadIdx.x; asm volatile("" : "+v"(tid_l)); const int lane = tid_l & 63, wave = __builtin_amdgcn_readfirstlane(tid_l >> 6), gw = vcu * NWAVES + wave, NGW = G * NWAVES; (void)lane; (void)gw; (void)NGW
    const int G = gridDim.x; const int bx = blockIdx.x; const int vcu = (G % 8 == 0) ? (bx % 8) * (G / 8) + bx / 8 : bx;
#define WSP(T, off) ((T*)(args.ws + (off)))
#define INF(i) ((const float*)args.in[i])
    gu32* ctl = (gu32*)(args.ws + WS_CTL);
    float* out = args.out;
    for (int u = threadIdx.x; u < (LDS_BYTES - MISC_OFF) / 4; u += NWAVES * 64) ((LAS unsigned*)(ldsl + MISC_OFF))[u] = 0u;
    __syncthreads();
    XcdBarrier bar = xcd_barrier_post((unsigned*)(ctl + CW_BAR), MISC + 8);
    const int lo = args.ph_lo, hi = args.ph_hi;
#ifndef MK_ATTN_FN
#define MK_ATTN_FN attn_block_dma
#endif
#ifndef MK_PFD
#define MK_PFD 0
#endif
#ifndef MK_SP2
#define MK_SP2 true
#endif
#ifndef MK_P4_NS
#define MK_P4_NS 0
#endif
#ifndef MK_P4_FS
#define MK_P4_FS 4
#endif
#ifndef MK_REP_ATT
#define MK_REP_ATT 1
#endif
#ifndef MK_REP_DEC
#define MK_REP_DEC 1
#endif
#ifndef MK_REP_CONV
#define MK_REP_CONV 1
#endif
#ifndef MK_REPEAT_MASK
#define MK_REPEAT_MASK 0
#endif
#define IN(k) (lo <= (k) && (k) < hi)
#define PH(k) if (IN(k)) for (int rep_ = 0; rep_ < (((MK_REPEAT_MASK) >> (k)) & 1) + 1; ++rep_, __syncthreads())
#ifndef MK_BAR_REPS
#define MK_BAR_REPS 1
#endif
#define GRID_BAR(k) do { if (IN(k) && IN((k) + 1)) for (int br_ = 0; br_ < MK_BAR_REPS; ++br_) xcd_barrier(bar); } while (0)
#ifndef MK_RSTD_LDS
#define MK_RSTD_LDS 1
#endif
#define RSTD_TABLE(stp, S_, E_) do { (E_).pml = -1; if (MK_RSTD_LDS) { const int pm0_ = (S_).pm_of(0); if (pm0_ >= 0) { int tt_ = threadIdx.x; asm volatile("" : "+v"(tt_)); \
        if (tt_ < 256) { const float* p_ = (stp) + (size_t)(pm0_ * 256 + tt_) * 8; const pg8::f32x4 x_ = *(const pg8::f32x4*)p_, y_ = *(const pg8::f32x4*)(p_ + 4); \
            ((LAS float*)(ldsl + RING_BYTES))[tt_] = __builtin_amdgcn_rsqf((((x_[0] + x_[1]) + (x_[2] + x_[3])) + ((y_[0] + y_[1]) + (y_[2] + y_[3]))) * (1.0f / 2048.0f) + 1e-6f); } \
        __syncthreads(); (E_).pml = pm0_; } } } while (0)
#ifndef MK_FASTSEAM
#define MK_FASTSEAM 1
#endif
    const bool fs_ = MK_FASTSEAM && G == 256 && lo == 0 && hi == N_PHASES && MK_REPEAT_MASK == 0;
#define SEAM_ARRIVE(s, S_) do { if (fs_) { asm volatile("s_waitcnt vmcnt(0)" ::: "memory"); __syncthreads(); \
        if (threadIdx.x == 0) { __builtin_amdgcn_fence(__ATOMIC_RELEASE, "agent"); asm volatile("s_waitcnt vmcnt(0)" ::: "memory"); \
            unsigned* c_ = (unsigned*)(ctl + CW_SEAM + (s) * 2048); \
            for (int i_ = 0, pm_; (pm_ = (S_).pm_of(i_)) >= 0; ++i_) (void)__hip_atomic_fetch_add(c_ + pm_ * 32, 1u, __ATOMIC_RELAXED, __HIP_MEMORY_SCOPE_AGENT); \
            (void)__hip_atomic_fetch_add(c_ + 1024, 1u, __ATOMIC_RELAXED, __HIP_MEMORY_SCOPE_AGENT); } } } while (0)
#define SEAM_WAIT(s, S_, target) do { if (fs_) { if (threadIdx.x == 0) { unsigned* c_ = (unsigned*)(ctl + CW_SEAM + (s) * 2048); \
            for (int i_ = 0, pm_; (pm_ = (S_).pm_of(i_)) >= 0; ++i_) XB_SPIN(xb_ld(c_ + pm_ * 32) < (unsigned)(target), (unsigned*)(ctl + CW_BAR)); \
            __builtin_amdgcn_fence(__ATOMIC_ACQUIRE, "agent"); asm volatile("s_waitcnt vmcnt(0)" ::: "memory"); } __syncthreads(); } } while (0)
#define SEAM_WAIT_S(s) do { if (fs_) { if (threadIdx.x == 0) { unsigned* c_ = (unsigned*)(ctl + CW_SEAM + (s) * 2048); \
            XB_SPIN(xb_ld(c_ + 1024) < (unsigned)G, (unsigned*)(ctl + CW_BAR)); \
            __builtin_amdgcn_fence(__ATOMIC_ACQUIRE, "agent"); asm volatile("s_waitcnt vmcnt(0)" ::: "memory"); } __syncthreads(); } } while (0)

    PH(0) {
        LOCAL_IDS();
        constexpr int I_GU = 32 * 176, I_DN = 88 * 64, I_IN = 32 * 160, I_PP = 4 * 64;
        constexpr int I_SQ = 32 * 64;
        constexpr int NITEMS = 4 * I_GU + 2 * I_DN + I_IN + I_PP + 2 * I_SQ;
        constexpr int O1 = 2 * I_GU, O2 = O1 + I_DN, O3 = O2 + I_SQ, O4 = O3 + I_SQ, O5 = O4 + I_PP, O6 = O5 + I_IN, O7 = O6 + I_DN, O8 = O7 + I_GU;
#define P0_DESC(it) ((it) < I_GU ? tr_desc(INF(25), INF(24), D, FF, WSP(bf16, WS_W3T), 1, (it)) : (it) < O1 ? tr_desc(INF(26), INF(24), D, FF, WSP(bf16, WS_W3T), 2, (it) - I_GU) : \
                     (it) < O2 ? tr_desc(INF(27), nullptr, FF, D, WSP(bf16, WS_W4T), 0, (it) - O1) : \
                     (it) < O3 ? tr_desc(INF(23), nullptr, D, D, WSP(bf16, WS_WOT), 0, (it) - O2) : \
                     (it) < O4 ? tr_desc(INF(29), INF(28), D, D, WSP(bf16, WS_WPGT), 0, (it) - O3) : \
                     (it) < O5 ? tr_desc(INF(30), nullptr, DPLE, D, WSP(bf16, WS_WPPT), 0, (it) - O4) : \
                     (it) < O6 ? tr_desc(INF(13), INF(12), D, NIN, WSP(bf16, WS_WINT), 3, (it) - O5) : \
                     (it) < O7 ? tr_desc(INF(11), nullptr, FF, D, WSP(bf16, WS_W2T), 0, (it) - O6) : \
                     (it) < O8 ? tr_desc(INF(9), INF(8), D, FF, WSP(bf16, WS_W1T), 1, (it) - O7) : tr_desc(INF(10), INF(8), D, FF, WSP(bf16, WS_W1T), 2, (it) - O8))
        TR_STREAM(NITEMS, gw, NGW, P0_DESC);
#undef P0_DESC
        {
        const float* x_prompt = INF(0); const float* x_sample = INF(1); const float* p_prompt = INF(6); const float* p_sample = INF(7);
        bf16* XB = WSP(bf16, WS_XB); bf16* PB = WSP(bf16, WS_PB); float* ST1 = WSP(float, WS_ST1);
        for (int m = gw; m < MREAL; m += NGW) {
            const float* xr = m < MP ? x_prompt + (size_t)m * D : x_sample + (size_t)(m - MP) * D;
            const GAS f32x4* xv = (const GAS f32x4*)xr + lane;
            f32x4 v[8]; float s = 0.f;
#pragma unroll
            for (int j = 0; j < 8; ++j) { v[j] = __builtin_nontemporal_load(xv + 64 * j); s += (v[j].x * v[j].x + v[j].y * v[j].y) + (v[j].z * v[j].z + v[j].w * v[j].w); }
            s = wave_sum(s);
            GAS unsigned long long* o8 = (GAS unsigned long long*)(XB + (size_t)m * D) + lane;
#pragma unroll
            for (int j = 0; j < 8; ++j) o8[64 * j] = (unsigned long long)pk2(v[j].x, v[j].y) | ((unsigned long long)pk2(v[j].z, v[j].w) << 32);
            if (lane < 2) *(GAS f32x4*)(ST1 + (size_t)m * 8 + 4 * lane) = (f32x4){lane == 0 ? s : 0.f, 0.f, 0.f, 0.f};
            const float* pr = m < MP ? p_prompt + (size_t)m * DPLE : p_sample + (size_t)(m - MP) * DPLE;
            const f32x4 pv = ((const GAS f32x4*)pr)[lane];
            ((GAS unsigned long long*)(PB + (size_t)m * DPLE))[lane] = (unsigned long long)pk2(pv.x, pv.y) | ((unsigned long long)pk2(pv.z, pv.w) << 32);
        }
        const int gt = gw * 64 + lane, NGT = NGW * 64;
        const float* state_conv = INF(4);
        for (int i = gt; i < DB * 22 * 256; i += NGT) { const int bs = i / (22 * 256), rem = i % (22 * 256), rr = rem >> 8, c4 = (rem & 255) * 4;
            *(GAS f32x4*)(out + OC_S + (size_t)(bs * 30 + rr) * CW + c4) = *(const GAS f32x4*)(state_conv + (size_t)(bs * 30 + rr + 8) * CW + c4); }
        }
    }
    GRID_BAR(0);

#define PJ_HALF(hf) do { const bool slk_ = (G == 256); const int cs_ = slk_ ? (bx >= 128 ? bx - 128 + 128 * (hf) : -1) : ((hf) == 0 ? bx : -1); \
        if (cs_ >= 0) { int kple = DPLE; asm volatile("" : "+s"(kple));          \
            pg8::Gemm g{WSP(bf16, WS_PB), WSP(bf16, WS_WPPT), MP, D, kple}; pg8::StaticOrder S; S.init(MP, D, slk_ ? 256 : G, cs_); pg8::EpiBf16 E{WSP(bf16, WS_PJ)}; \
            pg8::gemm_phase<pg8::EpiBf16, pg8::StaticOrder, true, MK_SP2, MK_PFD>(ldsl, g, S, E); } } while (0)
    PH(1) {
        { pg8::Gemm g{WSP(bf16, WS_XB), WSP(bf16, WS_W1T), MP, 2 * FF, D}; pg8::StaticOrder S; S.init(MP, 2 * FF, G, bx); pg8::EpiSwiGLU E{WSP(bf16, WS_ACT), WSP(float, WS_ST1), FF, -1};
          RSTD_TABLE(WSP(float, WS_ST1), S, E);
          pg8::gemm_phase<pg8::EpiSwiGLU, pg8::StaticOrder, true, MK_SP2, MK_PFD>(ldsl, g, S, E); }
        sk::swiglu_phase(WSP(bf16, WS_XB) + (size_t)MP * D, WSP(bf16, WS_W1T), WSP(bf16, WS_ACT) + (size_t)MP * FF, bx, G, (char*)lds);
        PJ_HALF(0);
        { pg8::StaticOrder S; S.init(MP, 2 * FF, G, bx); SEAM_ARRIVE(1, S); }
    }
    if (!fs_) GRID_BAR(1);
    PH(2) {
        pg8::Gemm g{WSP(bf16, WS_ACT), WSP(bf16, WS_W2T), MP, D, FF}; pg8::StaticOrder S; S.init(MP, D, G, bx);
        pg8::EpiResid<1> E{WSP(bf16, WS_XB), WSP(bf16, WS_H1B), WSP(float, WS_ST2)};
        SEAM_WAIT(1, S, 44);
        pg8::gemm_phase<pg8::EpiResid<1>, pg8::StaticOrder, true, MK_SP2, MK_PFD>(ldsl, g, S, E);
        SEAM_WAIT_S(1);
        sk::resid_phase<1, FF>(WSP(bf16, WS_ACT) + (size_t)MP * FF, WSP(bf16, WS_W2T), WSP(bf16, WS_XB) + (size_t)MP * D, WSP(bf16, WS_H1B) + (size_t)MP * D, bx, G, (char*)lds);
        SEAM_ARRIVE(2, S);
    }
    if (!fs_) GRID_BAR(2);
    PH(3) {
        pg8::Gemm g{WSP(bf16, WS_H1B), WSP(bf16, WS_WINT), MP, NIN, D}; pg8::StaticOrder S; S.init(MP, NIN, G, bx);
        pg8::EpiWin E{WSP(float, WS_ST2), WSP(bf16, WS_QB), (WS_KB - WS_QB) / 2, WSP(bf16, WS_U), out, -1};
        SEAM_WAIT(2, S, 8);
        if (fs_) RSTD_TABLE(WSP(float, WS_ST2), S, E);
        pg8::gemm_phase<pg8::EpiWin, pg8::StaticOrder, true, MK_SP2, MK_PFD>(ldsl, g, S, E);
        SEAM_WAIT_S(2);
        sk::win_phase(WSP(bf16, WS_H1B) + (size_t)MP * D, WSP(bf16, WS_WINT), WSP(bf16, WS_QB) + (size_t)MP * 1024, (WS_KB - WS_QB) / 2, WSP(bf16, WS_U) + (size_t)MP * 1024, out, bx, G, (char*)lds);
        PJ_HALF(1);
    }
    GRID_BAR(3);
    PH(4) {
        LOCAL_IDS();
        float lam; { const float a = INF(14)[lane] * INF(15)[lane], b = INF(16)[lane] * INF(17)[lane]; lam = __expf(wave_sum(a)) - __expf(wave_sum(b)) + 0.2f; }
        const int bh = vcu >> 3, s8 = vcu & 7, ab = bh >> 3, ah = bh & 7;
        const float c1 = 8.0f * __builtin_amdgcn_exp2f(-(float)(ah + 1));
#if MK_P4_NS > 0
        {
            const int rs0 = (vcu * MK_P4_NS) >> 8, rs1 = ((vcu + 1) * MK_P4_NS) >> 8;
            const bool streamer = rs1 > rs0;
            const int NC = 256 - MK_P4_NS, rc = vcu - rs0;
            if (streamer) {
                for (int u = rs0; u < 256; u += MK_P4_NS) att::decode_unit(u >> 5, u & 31, INF(2), INF(3), (const int*)args.in[5], WSP(bf16, WS_QB), WSP(float, WS_DPO), WSP(float, WS_DPM), WSP(float, WS_DPL), (char*)lds);
            } else {
                for (int j = 0; j * NC < 512; ++j) {
                    const int idx = j * NC + ((j & 1) ? NC - 1 - rc : rc);
                    if (idx < 512) { const int qb = 15 - (idx >> 5), bh2 = idx & 31; const float c1b = 8.0f * __builtin_amdgcn_exp2f(-(float)((bh2 & 7) + 1));
                        att::MK_ATTN_FN(WSP(bf16, WS_QB), WSP(bf16, WS_KB), WSP(bf16, WS_VB), WSP(bf16, WS_AO), (bh2 >> 3) * SEQ, qb * 128, bh2 & 7, c1b, lam, INF(18), (char*)lds); }
                }
                for (int cu = rc; cu < 512 + 64; cu += NC) att::conv_unit(cu, WSP(bf16, WS_U), INF(4), INF(19), INF(20), INF(21), INF(22), WSP(bf16, WS_AO), (char*)lds);
            }
        }
    }
#else
#ifndef MK_CONV_BAL
#define MK_CONV_BAL 1
#endif
        const bool cbal_ = MK_CONV_BAL && G == 256 && MK_REP_CONV == 1 && MK_REP_DEC == 1;
        for (int pass = 0; pass < 2; ++pass) {
#ifndef MK_P4_BH
#define MK_P4_BH 1
#endif
            int cu0_ = 0, cu1_ = 0, cus_ = 1;
            if ((pass ^ ((MK_P4_BH ? (((vcu >> 3) & 1) == 0) : ((vcu & 7) < MK_P4_FS)) ? 0 : 1)) == 0) {
                for (int rd_ = 0; rd_ < MK_REP_DEC; ++rd_) att::decode_unit(vcu >> 5, vcu & 31, INF(2), INF(3), (const int*)args.in[5], WSP(bf16, WS_QB), WSP(float, WS_DPO), WSP(float, WS_DPM), WSP(float, WS_DPL), (char*)lds);
                if (cbal_ && (vcu & 3) == 0) { cu0_ = 512 + (vcu >> 2); cu1_ = 512 + 64; cus_ = 1024; }
            } else {
                for (int k = 0; k < 2 * MK_REP_ATT; ++k)
                    att::MK_ATTN_FN(WSP(bf16, WS_QB), WSP(bf16, WS_KB), WSP(bf16, WS_VB), WSP(bf16, WS_AO), ab * SEQ, ((k & 1) ? 15 - s8 : s8) * 128, ah, c1, lam, INF(18), (char*)lds);
                cu0_ = vcu; cu1_ = cbal_ ? 512 : 512 + 64; cus_ = G;
            }
            __syncthreads();
            for (int rc_ = 0; rc_ < MK_REP_CONV; ++rc_) for (int cu = cu0_; cu < cu1_; cu += cus_) att::conv_unit(cu, WSP(bf16, WS_U), INF(4), INF(19), INF(20), INF(21), INF(22), WSP(bf16, WS_AO), (char*)lds);
        }
    }
#endif
    GRID_BAR(4);
    PH(5) {
        LOCAL_IDS();
        float lam; { const float a = INF(14)[lane] * INF(15)[lane], b = INF(16)[lane] * INF(17)[lane]; lam = __expf(wave_sum(a)) - __expf(wave_sum(b)) + 0.2f; }
        for (int it = wave * G + vcu; it < DB * NH * DT; it += NGW)
            att::decode_combine(it, WSP(bf16, WS_QB), WSP(bf16, WS_KB), WSP(bf16, WS_VB), WSP(float, WS_DPO), WSP(float, WS_DPM), WSP(float, WS_DPL), WSP(bf16, WS_AO), lam, INF(18), lane);
    }
    GRID_BAR(5);
    PH(6) {
        pg8::Gemm g{WSP(bf16, WS_AO), WSP(bf16, WS_WOT), MP, D, D}; pg8::StaticOrder S; S.init(MP, D, G, bx);
        pg8::EpiResid<2> E{WSP(bf16, WS_H1B), WSP(bf16, WS_H2B), WSP(float, WS_ST3)};
        pg8::gemm_phase<pg8::EpiResid<2>, pg8::StaticOrder, true, MK_SP2, MK_PFD>(ldsl, g, S, E);
        sk::resid_phase<2, D>(WSP(bf16, WS_AO) + (size_t)MP * D, WSP(bf16, WS_WOT), WSP(bf16, WS_H1B) + (size_t)MP * D, WSP(bf16, WS_H2B) + (size_t)MP * D, bx, G, (char*)lds);
        SEAM_ARRIVE(6, S);
    }
    if (!fs_) GRID_BAR(6);
    PH(7) {
        pg8::Gemm g{WSP(bf16, WS_H2B), WSP(bf16, WS_W3T), MP, 2 * FF, D}; pg8::StaticOrder S; S.init(MP, 2 * FF, G, bx); pg8::EpiSwiGLU E{WSP(bf16, WS_ACT), WSP(float, WS_ST3), FF, -1};
        SEAM_WAIT(6, S, 8);
        if (fs_) RSTD_TABLE(WSP(float, WS_ST3), S, E);
        pg8::gemm_phase<pg8::EpiSwiGLU, pg8::StaticOrder, true, MK_SP2, MK_PFD>(ldsl, g, S, E);
        SEAM_WAIT_S(6);
        sk::swiglu_phase(WSP(bf16, WS_H2B) + (size_t)MP * D, WSP(bf16, WS_W3T), WSP(bf16, WS_ACT) + (size_t)MP * FF, bx, G, (char*)lds);
        SEAM_ARRIVE(7, S);
    }
    if (!fs_) GRID_BAR(7);
    PH(8) {
        pg8::Gemm g{WSP(bf16, WS_ACT), WSP(bf16, WS_W4T), MP, D, FF}; pg8::StaticOrder S; S.init(MP, D, G, bx);
        pg8::EpiResid<1> E{WSP(bf16, WS_H2B), WSP(bf16, WS_H3B), WSP(float, WS_ST4)};
        SEAM_WAIT(7, S, 44);
        pg8::gemm_phase<pg8::EpiResid<1>, pg8::StaticOrder, true, MK_SP2, MK_PFD>(ldsl, g, S, E);
        SEAM_WAIT_S(7);
        sk::resid_phase<1, FF>(WSP(bf16, WS_ACT) + (size_t)MP * FF, WSP(bf16, WS_W4T), WSP(bf16, WS_H2B) + (size_t)MP * D, WSP(bf16, WS_H3B) + (size_t)MP * D, bx, G, (char*)lds);
        SEAM_ARRIVE(8, S);
    }
    if (!fs_) GRID_BAR(8);
    PH(9) {
        pg8::Gemm g{WSP(bf16, WS_H3B), WSP(bf16, WS_WPGT), MP, D, D}; pg8::StaticOrder S; S.init(MP, D, G, bx); pg8::EpiPle E{WSP(float, WS_ST4), WSP(bf16, WS_H3B), WSP(bf16, WS_PJ), WSP(bf16, WS_H4), -1};
        SEAM_WAIT(8, S, 8);
        if (fs_) RSTD_TABLE(WSP(float, WS_ST4), S, E);
        pg8::gemm_phase<pg8::EpiPle, pg8::StaticOrder, true, MK_SP2, MK_PFD>(ldsl, g, S, E);
        SEAM_WAIT_S(8);
        sk::ple_phase(WSP(bf16, WS_H3B) + (size_t)MP * D, WSP(bf16, WS_WPGT), WSP(bf16, WS_PB) + (size_t)MP * DPLE, WSP(bf16, WS_WPPT), WSP(bf16, WS_H4) + (size_t)MP * D, bx, G, (char*)lds);
    }
    GRID_BAR(9);
    PH(10) {
        LOCAL_IDS();
        const bf16* H4 = WSP(bf16, WS_H4); const float* g_final = INF(31);
        for (int m = gw; m < MREAL; m += NGW) {
            const GAS v4u* hv = (const GAS v4u*)(H4 + (size_t)m * D) + lane;
            v4u raw[4]; float s = 0.f;
#pragma unroll
            for (int j = 0; j < 4; ++j) raw[j] = HO_LD(hv + 64 * j);
            f32x4 v[8];
#pragma unroll
            for (int j = 0; j < 4; ++j) {
                v[2 * j] = (f32x4){__uint_as_float(raw[j].x << 16), __uint_as_float(raw[j].x & 0xffff0000u), __uint_as_float(raw[j].y << 16), __uint_as_float(raw[j].y & 0xffff0000u)};
                v[2 * j + 1] = (f32x4){__uint_as_float(raw[j].z << 16), __uint_as_float(raw[j].z & 0xffff0000u), __uint_as_float(raw[j].w << 16), __uint_as_float(raw[j].w & 0xffff0000u)};
            }
#pragma unroll
            for (int j = 0; j < 8; ++j) s += (v[j].x * v[j].x + v[j].y * v[j].y) + (v[j].z * v[j].z + v[j].w * v[j].w);
            const float r = __builtin_amdgcn_rsqf(wave_sum(s) * (1.0f / D) + 1e-6f);
            float* orow = m < MP ? out + OY_P + (size_t)m * D : out + OY_S + (size_t)(m - MP) * D;
#pragma unroll
            for (int j = 0; j < 4; ++j) { const int c0 = 8 * lane + 512 * j;
                const f32x4 g0 = *(const GAS f32x4*)(g_final + c0), g1 = *(const GAS f32x4*)(g_final + c0 + 4);
                __builtin_nontemporal_store(v[2 * j] * r * g0, (GAS f32x4*)(orow + c0)); __builtin_nontemporal_store(v[2 * j + 1] * r * g1, (GAS f32x4*)(orow + c0 + 4)); }
        }
    }
#ifdef MK_TAIL_DEC
    { __syncthreads(); if (MK_TAIL_DEC == 2 || (vcu & 1) == 0) att::decode_unit(vcu >> 5, vcu & 31, INF(2), INF(3), (const int*)args.in[5], WSP(bf16, WS_QB), WSP(float, WS_DPO), WSP(float, WS_DPM), WSP(float, WS_DPL), (char*)lds); }
#endif
#ifdef MK_TAIL_MIX
    { __syncthreads(); const int bh = vcu >> 3, s8 = vcu & 7, ab = bh >> 3, ah = bh & 7; const float c1 = 8.0f * __builtin_amdgcn_exp2f(-(float)(ah + 1));
      float lam; { LOCAL_IDS(); const float a = INF(14)[lane] * INF(15)[lane], b = INF(16)[lane] * INF(17)[lane]; lam = __expf(wave_sum(a)) - __expf(wave_sum(b)) + 0.2f; }
      if ((vcu & 1) == 0) att::decode_unit(vcu >> 5, vcu & 31, INF(2), INF(3), (const int*)args.in[5], WSP(bf16, WS_QB), WSP(float, WS_DPO), WSP(float, WS_DPM), WSP(float, WS_DPL), (char*)lds);
      else { for (int k = 0; k < 2; ++k) att::MK_ATTN_FN(WSP(bf16, WS_QB), WSP(bf16, WS_KB), WSP(bf16, WS_VB), WSP(bf16, WS_AO), ab * SEQ, ((k & 1) ? 15 - s8 : s8) * 128, ah, c1, lam, INF(18), (char*)lds); } }
#endif
#ifdef MK_TAIL_ATT
    { __syncthreads(); const int bh = vcu >> 3, s8 = vcu & 7, ab = bh >> 3, ah = bh & 7; const float c1 = 8.0f * __builtin_amdgcn_exp2f(-(float)(ah + 1));
      float lam; { LOCAL_IDS(); const float a = INF(14)[lane] * INF(15)[lane], b = INF(16)[lane] * INF(17)[lane]; lam = __expf(wave_sum(a)) - __expf(wave_sum(b)) + 0.2f; }
      if (MK_TAIL_ATT == 1) { for (int k = 0; k < 2; ++k) att::MK_ATTN_FN(WSP(bf16, WS_QB), WSP(bf16, WS_KB), WSP(bf16, WS_VB), WSP(bf16, WS_AO), ab * SEQ, ((k & 1) ? 15 - s8 : s8) * 128, ah, c1, lam, INF(18), (char*)lds); }
      else { for (int cu = vcu; cu < 512 + 64; cu += G) att::conv_unit(cu, WSP(bf16, WS_U), INF(4), INF(19), INF(20), INF(21), INF(22), WSP(bf16, WS_AO), (char*)lds); } }
#endif
#undef PJ_HALF
#undef IN
#undef PH
#undef GRID_BAR
#undef WSP
#undef INF
}
}

extern "C" void kernel_launch(void* const* d_in, const int* in_sizes, int n_in, void* d_out, int out_size, void* d_ws, size_t ws_size, hipStream_t stream) {
    using namespace mk;
    static int grid = 0;
    if (grid == 0) {
        if (n_in != 32 || out_size != (int)O_END || ws_size < WS_END) { fprintf(stderr, "kernel_launch: unexpected problem shape (n_in %d, out %d, ws %zu); nothing launched\n", n_in, out_size, ws_size); grid = -1; return; }
        int dev = 0, cus = 0, per_cu = 0;
        if (hipGetDevice(&dev) != hipSuccess || hipDeviceGetAttribute(&cus, hipDeviceAttributeMultiprocessorCount, dev) != hipSuccess) { grid = -1; return; }
        if (hipFuncSetAttribute((const void*)hymba_fwd, hipFuncAttributeMaxDynamicSharedMemorySize, LDS_BYTES) != hipSuccess) { fprintf(stderr, "kernel_launch: hipFuncSetAttribute failed\n"); grid = -1; return; }
        if (hipOccupancyMaxActiveBlocksPerMultiprocessor(&per_cu, (const void*)hymba_fwd, NWAVES * 64, LDS_BYTES) != hipSuccess || per_cu < 1)
            fprintf(stderr, "kernel_launch: note: occupancy query reports %d workgroups per CU\n", per_cu);
        (void)hipGetLastError();
        grid = cus;
    }
    if (grid < 0) return;
    if (hipMemsetAsync((char*)d_ws + WS_CTL, 0, CTL_ZERO_BYTES, stream) != hipSuccess) return;
    Args a{};
    for (int i = 0; i < 32; ++i) a.in[i] = d_in[i];
    a.out = (float*)d_out; a.ws = (unsigned char*)d_ws;
#ifndef MK_N_LAUNCHES
#define MK_N_LAUNCHES 1
#endif
    if (MK_N_LAUNCHES == 1) { a.ph_lo = 0; a.ph_hi = N_PHASES; hipLaunchKernelGGL(hymba_fwd, dim3(grid), dim3(NWAVES * 64), LDS_BYTES, stream, a); }
    else { for (int p = 0; p < N_PHASES; ++p) { a.ph_lo = p; a.ph_hi = p + 1; hipLaunchKernelGGL(hymba_fwd, dim3(grid), dim3(NWAVES * 64), LDS_BYTES, stream, a); } }
}
```
